# Optimizing an MI355X kernel written in HIP

```python
import functools
import jax
import jax.numpy as jnp
from jax import lax
import numpy as np

D_MODEL = 1024
BATCH = 16
SEQ = 256
DEPTH = 2
DEC_BATCH = 2
DEC_SEQ = 2048
PAST_LEN = 512

GRID_W = 64
ROPE_BASE = 10000.0
NORM_EPS = 1e-6
Q_BLOCK = 128
N_MOD = 9
D_FF = 2816

MLA_HEADS = 8
MLA_Q_LORA = 384
MLA_KV_LORA = 256
MLA_NOPE = 64
MLA_ROPE = 32
MLA_V = 64

SWA_HEADS = 8
SWA_KV_HEADS = 2
SWA_GROUP = SWA_HEADS // SWA_KV_HEADS
SWA_HD = 64
SWA_WINDOW = 128

GDN_HEADS = 4
GDN_DK = 128
GDN_DV = 128
GDN_CONV = 5
GDN_CHUNK = 64
GDN_QK_DIM = GDN_HEADS * GDN_DK
GDN_V_DIM = GDN_HEADS * GDN_DV
GDN_CONV_CH = 2 * GDN_QK_DIM + GDN_V_DIM

IN_SPLIT_SIZES = (MLA_Q_LORA, MLA_KV_LORA, MLA_ROPE,
                  SWA_HEADS * SWA_HD, SWA_KV_HEADS * SWA_HD, SWA_KV_HEADS * SWA_HD,
                  GDN_QK_DIM, GDN_QK_DIM, GDN_V_DIM, GDN_V_DIM, 4 * GDN_HEADS)
IN_DIM = (MLA_Q_LORA + MLA_KV_LORA + MLA_ROPE + SWA_HEADS * SWA_HD + 2 * SWA_KV_HEADS * SWA_HD
          + 2 * GDN_QK_DIM + 2 * GDN_V_DIM + 4 * GDN_HEADS)
D_MIX = MLA_HEADS * MLA_V + SWA_HEADS * SWA_HD + GDN_HEADS * GDN_DV

kernel_name = 'hybrid_mla_swa_gdn_macaron_diffusion_step'


def rms_norm(x, gain):
    xf = x.astype(jnp.float32)
    y = xf * lax.rsqrt(jnp.mean(xf * xf, axis=-1, keepdims=True) + NORM_EPS)
    return (y * gain.astype(jnp.float32)).astype(x.dtype)


def l2_normalize(x):
    xf = x.astype(jnp.float32)
    return (xf * lax.rsqrt(jnp.sum(xf * xf, axis=-1, keepdims=True) + 1e-6)).astype(x.dtype)


def modulate(x, shift, scale):
    return x * (1 + scale) + shift


def adaln_params(cond, w_ada, b_ada):
    m = jax.nn.silu(cond) @ w_ada + b_ada
    return jnp.split(m[:, None, :], N_MOD, axis=-1)


def swiglu(h, w1, w2):
    gate, up = jnp.split(h @ w1, 2, axis=-1)
    return (jax.nn.silu(gate) * up) @ w2


def axial_rope_tables(n_tokens, dim):
    rows = n_tokens // GRID_W
    row = jnp.repeat(jnp.arange(rows, dtype=jnp.float32), GRID_W)
    col = jnp.tile(jnp.arange(GRID_W, dtype=jnp.float32), rows)
    axis_dim = dim // 2
    inv_freq = 1.0 / (ROPE_BASE ** (jnp.arange(0, axis_dim, 2, dtype=jnp.float32) / axis_dim))
    ang_r = row[:, None] * inv_freq[None, :]
    ang_c = col[:, None] * inv_freq[None, :]
    ang = jnp.concatenate([ang_r, ang_r, ang_c, ang_c], axis=-1)
    return jnp.cos(ang), jnp.sin(ang)


def rotate_half(z):
    z1, z2 = jnp.split(z, 2, axis=-1)
    return jnp.concatenate([-z2, z1], axis=-1)


def apply_rope(x, cos, sin):
    shape = (cos.shape[0],) + (1,) * (x.ndim - 3) + (cos.shape[1],)
    xf = x.astype(jnp.float32)
    half = x.shape[-1] // 2
    rot = jnp.concatenate([rotate_half(xf[..., :half]), rotate_half(xf[..., half:])], axis=-1)
    return (xf * cos.reshape(shape) + rot * sin.reshape(shape)).astype(x.dtype)


def centred_depthwise_conv(x, w):
    k = w.shape[0]
    return lax.conv_general_dilated(x, w[:, None, :], window_strides=(1,), padding=[(k // 2, k // 2)],
                                    dimension_numbers=('NWC', 'WIO', 'NWC'),
                                    feature_group_count=x.shape[-1])


def project_mixers(h, lp):
    b, t, _ = h.shape
    offsets = np.cumsum(IN_SPLIT_SIZES)[:-1].tolist()
    u = h @ lp['w_in']
    cq, ckv, krope, sq, sk, sv, gq, gk, gv, gz, gates = jnp.split(u, offsets, axis=-1)
    q = (rms_norm(cq, lp['mla_q_norm']) @ lp['mla_w_qb']).reshape(b, t, MLA_HEADS, MLA_NOPE + MLA_ROPE)
    qkv = jax.nn.silu(centred_depthwise_conv(jnp.concatenate([gq, gk, gv], axis=-1), lp['gdn_conv_w']))
    gq, gk, gv = jnp.split(qkv, [GDN_QK_DIM, 2 * GDN_QK_DIM], axis=-1)
    gates = gates.reshape(b, t, 2, 2, GDN_HEADS)
    return {
        'q_nope': q[..., :MLA_NOPE], 'q_rope': q[..., MLA_NOPE:],
        'ckv': rms_norm(ckv, lp['mla_kv_norm']), 'krope': krope,
        'sq': sq.reshape(b, t, SWA_KV_HEADS, SWA_GROUP, SWA_HD),
        'sk': sk.reshape(b, t, SWA_KV_HEADS, SWA_HD),
        'sv': sv.reshape(b, t, SWA_KV_HEADS, SWA_HD),
        'gq': l2_normalize(gq.reshape(b, t, GDN_HEADS, GDN_DK)),
        'gk': l2_normalize(gk.reshape(b, t, GDN_HEADS, GDN_DK)),
        'gv': gv.reshape(b, t, GDN_HEADS, GDN_DV),
        'gz': gz.reshape(b, t, GDN_HEADS, GDN_DV),
        'ga': gates[:, :, 0], 'gb': gates[:, :, 1],
    }


def mla_expand(ckv, w_kvb):
    b, s, _ = ckv.shape
    kv = (ckv @ w_kvb).reshape(b, s, MLA_HEADS, MLA_NOPE + MLA_V)
    return kv[..., :MLA_NOPE], kv[..., MLA_NOPE:]


def mla_attend(q_nope, q_rope, k_nope, k_rope, v):
    b, t, h, _ = q_nope.shape
    nb = t // Q_BLOCK
    scale = (MLA_NOPE + MLA_ROPE) ** -0.5

    def blocks(z):
        return jnp.swapaxes(z.reshape((b, nb, Q_BLOCK) + z.shape[2:]), 0, 1)

    def one(qs):
        qn, qr = qs
        s = (jnp.einsum('bqhd,bshd->bhqs', qn, k_nope)
             + jnp.einsum('bqhr,bsr->bhqs', qr, k_rope)).astype(jnp.float32) * scale
        p = jax.nn.softmax(s, axis=-1).astype(v.dtype)
        return jnp.einsum('bhqs,bshd->bqhd', p, v)

    o = lax.map(one, (blocks(q_nope), blocks(q_rope)))
    return jnp.swapaxes(o, 0, 1).reshape(b, t, h * MLA_V)


def gqa_sink_attend(q, k, v, sink):
    b, t, kvh, g, d = q.shape
    nb = t // Q_BLOCK
    scale = d ** -0.5
    snk = sink.reshape(kvh, g)[None, :, :, None, None].astype(jnp.float32)
    qb = jnp.swapaxes(q.reshape(b, nb, Q_BLOCK, kvh, g, d), 0, 1)

    def one(q_blk):
        s = jnp.einsum('bqkgd,bskd->bkgqs', q_blk, k).astype(jnp.float32) * scale
        s = jnp.concatenate([s, jnp.broadcast_to(snk, s.shape[:-1] + (1,))], axis=-1)
        p = jax.nn.softmax(s, axis=-1)[..., :-1].astype(v.dtype)
        return jnp.einsum('bkgqs,bskd->bqkgd', p, v)

    o = lax.map(one, qb)
    return jnp.swapaxes(o, 0, 1).reshape(b, t, kvh * g * d)


def swa_band_attend(q, k, v, k_ctx, v_ctx, sink):
    b, t, kvh, g, d = q.shape
    w = SWA_WINDOW
    nb = t // w
    scale = d ** -0.5
    qb = q.reshape(b, nb, w, kvh, g, d)

    def band(z):
        zp = jnp.pad(z, ((0, 0), (w, w), (0, 0), (0, 0))).reshape(b, nb + 2, w, kvh, d)
        return jnp.concatenate([zp[:, :-2], zp[:, 1:-1], zp[:, 2:]], axis=2)

    kb, vb = band(k), band(v)
    qi = jnp.arange(nb)[:, None] * w + jnp.arange(w)[None, :]
    kj = (jnp.arange(nb)[:, None] - 1) * w + jnp.arange(3 * w)[None, :]
    valid = ((jnp.abs(qi[:, :, None] - kj[:, None, :]) <= w)
             & (kj[:, None, :] >= 0) & (kj[:, None, :] < t))
    s_loc = jnp.einsum('bnqkgd,bnskd->bnkgqs', qb, kb).astype(jnp.float32) * scale
    s_loc = jnp.where(valid[None, :, None, None], s_loc, -jnp.inf)
    s_ctx = jnp.einsum('bnqkgd,blkd->bnkgql', qb, k_ctx).astype(jnp.float32) * scale
    snk = jnp.broadcast_to(sink.reshape(kvh, g)[None, None, :, :, None, None].astype(jnp.float32),
                           s_loc.shape[:-1] + (1,))
    p = jax.nn.softmax(jnp.concatenate([s_loc, s_ctx, snk], axis=-1), axis=-1)
    p_loc = p[..., :3 * w].astype(v.dtype)
    p_ctx = p[..., 3 * w:-1].astype(v.dtype)
    o = (jnp.einsum('bnkgqs,bnskd->bnqkgd', p_loc, vb)
         + jnp.einsum('bnkgql,blkd->bnqkgd', p_ctx, v_ctx))
    return o.reshape(b, t, kvh * g * d)


def gated_delta_chunked(q, k, v, g, beta, s0):
    b, t, h, dk = q.shape
    dv = v.shape[-1]
    c = GDN_CHUNK
    n = t // c

    def chunks(z):
        return z.astype(jnp.float32).reshape(b, n, c, h, -1).transpose(0, 3, 1, 2, 4)

    qc = chunks(q) * dk ** -0.5
    kc = chunks(k)
    vc = chunks(v)
    gc = jnp.cumsum(g.astype(jnp.float32).reshape(b, n, c, h).transpose(0, 3, 1, 2), axis=-1)
    bc = beta.astype(jnp.float32).reshape(b, n, c, h).transpose(0, 3, 1, 2)
    causal = jnp.tril(jnp.ones((c, c), dtype=bool))
    strict = jnp.tril(jnp.ones((c, c), dtype=bool), -1)
    decay = jnp.exp(jnp.where(causal, gc[..., :, None] - gc[..., None, :], -jnp.inf))
    kb = kc * bc[..., None]
    lower = jnp.where(strict, jnp.einsum('bhnid,bhnjd->bhnij', kb, kc) * decay, 0.0)
    eye = jnp.eye(c, dtype=jnp.float32)
    tinv = lax.linalg.triangular_solve(eye + lower, jnp.broadcast_to(eye, lower.shape),
                                       left_side=True, lower=True)
    u = tinv @ (vc * bc[..., None])
    wk = tinv @ (kb * jnp.exp(gc)[..., None])
    a_intra = jnp.where(causal, jnp.einsum('bhnid,bhnjd->bhnij', qc, kc) * decay, 0.0)
    q_dec = qc * jnp.exp(gc)[..., None]
    k_dec = kc * jnp.exp(gc[..., -1:] - gc)[..., None]
    g_tot = jnp.exp(gc[..., -1])

    def step(s, xs):
        w_i, u_i, qd_i, kd_i, a_i, gt_i = xs
        v_new = u_i - w_i @ s
        o_i = qd_i @ s + a_i @ v_new
        s = s * gt_i[..., None, None] + jnp.swapaxes(kd_i, -1, -2) @ v_new
        return s, o_i

    xs = tuple(jnp.moveaxis(z, 2, 0) for z in (wk, u, q_dec, k_dec, a_intra, g_tot))
    s_fin, o = lax.scan(step, s0.astype(jnp.float32), xs)
    o = o.transpose(1, 0, 3, 2, 4).reshape(b, t, h, dv)
    return o.astype(v.dtype), s_fin


def gdn_bidirectional(pr, lp, s_fwd0, s_bwd0):
    b, t = pr['gq'].shape[:2]
    g = -jnp.exp(lp['gdn_a_log'].astype(jnp.float32)) * jax.nn.softplus(
        pr['ga'].astype(jnp.float32) + lp['gdn_dt_bias'].astype(jnp.float32))
    beta = jax.nn.sigmoid(pr['gb'].astype(jnp.float32))
    q, k, v = pr['gq'], pr['gk'], pr['gv']
    o_f, s_f = gated_delta_chunked(q, k, v, g[:, :, 0], beta[:, :, 0], s_fwd0)

    def rev(z):
        return jnp.flip(z, axis=1)

    o_b, s_b = gated_delta_chunked(rev(q), rev(k), rev(v), rev(g[:, :, 1]), rev(beta[:, :, 1]), s_bwd0)
    o = rms_norm(o_f + rev(o_b), lp['gdn_norm']) * jax.nn.silu(pr['gz'])
    return o.reshape(b, t, GDN_HEADS * GDN_DV), jnp.stack([s_f, s_b], axis=1)


def mixer_context(h, lp):
    b = h.shape[0]
    pr = project_mixers(h, lp)
    k_nope, v = mla_expand(pr['ckv'], lp['mla_w_kvb'])
    o_mla = mla_attend(pr['q_nope'], pr['q_rope'], k_nope, pr['krope'], v)
    o_swa = gqa_sink_attend(pr['sq'], pr['sk'], pr['sv'], lp['swa_sink'])
    zero = jnp.zeros((b, GDN_HEADS, GDN_DK, GDN_DV), jnp.float32)
    o_gdn, st = gdn_bidirectional(pr, lp, zero, zero)
    out = jnp.concatenate([o_mla, o_swa, o_gdn], axis=-1) @ lp['w_out']
    return out, (pr['ckv'], pr['krope'], pr['sk'], pr['sv'], st)


def mixer_latent(h, lp, ctx):
    ckv_c, krope_c, sk_c, sv_c, st_c = ctx
    t = h.shape[1]
    pr = project_mixers(h, lp)
    cos_m, sin_m = axial_rope_tables(t, MLA_ROPE)
    cos_s, sin_s = axial_rope_tables(t, SWA_HD)
    kn_l, v_l = mla_expand(pr['ckv'], lp['mla_w_kvb'])
    kn_c, v_c = mla_expand(ckv_c, lp['mla_w_kvb'])
    o_mla = mla_attend(pr['q_nope'], apply_rope(pr['q_rope'], cos_m, sin_m),
                       jnp.concatenate([kn_l, kn_c], axis=1),
                       jnp.concatenate([apply_rope(pr['krope'], cos_m, sin_m), krope_c], axis=1),
                       jnp.concatenate([v_l, v_c], axis=1))
    o_swa = swa_band_attend(apply_rope(pr['sq'], cos_s, sin_s), apply_rope(pr['sk'], cos_s, sin_s),
                            pr['sv'], sk_c, sv_c, lp['swa_sink'])
    o_gdn, _ = gdn_bidirectional(pr, lp, st_c[:, 0], st_c[:, 1])
    out = jnp.concatenate([o_mla, o_swa, o_gdn], axis=-1) @ lp['w_out']
    return out, None


def macaron_layer(x, mod, lp, mix_fn):
    sh1, sc1, g1, sh2, sc2, g2, sh3, sc3, g3 = mod
    x = x + g1 * (0.5 * swiglu(modulate(rms_norm(x, lp['norm_ffn1']), sh1, sc1), lp['ffn1_w1'], lp['ffn1_w2']))
    m, aux = mix_fn(modulate(rms_norm(x, lp['norm_mix']), sh2, sc2))
    x = x + g2 * m
    x = x + g3 * (0.5 * swiglu(modulate(rms_norm(x, lp['norm_ffn2']), sh3, sc3), lp['ffn2_w1'], lp['ffn2_w2']))
    return x, aux


def setup_inputs(seed: int = 0) -> dict:
    key = jax.random.key(seed)
    ks = list(jax.random.split(key, 32))

    def nrm(i, shape, scale):
        return jax.random.normal(ks[i], shape, jnp.float32) * scale

    L = DEPTH
    dt = jax.random.uniform(ks[20], (L, 2, GDN_HEADS), jnp.float32, minval=1e-3, maxval=1e-1)
    return {
        'x_prompt': nrm(0, (BATCH, SEQ, D_MODEL), 1.0),
        'x_sample': nrm(1, (DEC_BATCH, DEC_SEQ, D_MODEL), 1.0),
        'cache_mla_ckv': nrm(2, (DEC_BATCH, DEPTH, PAST_LEN, MLA_KV_LORA), 1.0),
        'cache_mla_krope': nrm(3, (DEC_BATCH, DEPTH, PAST_LEN, MLA_ROPE), 1.0),
        'cache_swa_k': nrm(4, (DEC_BATCH, DEPTH, PAST_LEN, SWA_KV_HEADS, SWA_HD), 1.0),
        'cache_swa_v': nrm(5, (DEC_BATCH, DEPTH, PAST_LEN, SWA_KV_HEADS, SWA_HD), 1.0),
        'state_gdn': nrm(6, (DEC_BATCH, DEPTH, 2, GDN_HEADS, GDN_DK, GDN_DV), 0.1),
        'c': nrm(7, (DEC_BATCH, D_MODEL), 1.0),
        'c_ctx': nrm(8, (D_MODEL,), 1.0),
        'w_ada': nrm(9, (L, D_MODEL, N_MOD * D_MODEL), 0.5 * D_MODEL ** -0.5),
        'b_ada': nrm(10, (L, N_MOD * D_MODEL), 0.02),
        'norm_ffn1': 1.0 + nrm(11, (L, D_MODEL), 0.05),
        'ffn1_w1': nrm(12, (L, D_MODEL, 2 * D_FF), D_MODEL ** -0.5),
        'ffn1_w2': nrm(13, (L, D_FF, D_MODEL), D_FF ** -0.5),
        'norm_mix': 1.0 + nrm(14, (L, D_MODEL), 0.05),
        'w_in': nrm(15, (L, D_MODEL, IN_DIM), D_MODEL ** -0.5),
        'mla_q_norm': 1.0 + nrm(16, (L, MLA_Q_LORA), 0.05),
        'mla_w_qb': nrm(17, (L, MLA_Q_LORA, MLA_HEADS * (MLA_NOPE + MLA_ROPE)), MLA_Q_LORA ** -0.5),
        'mla_kv_norm': 1.0 + nrm(18, (L, MLA_KV_LORA), 0.05),
        'mla_w_kvb': nrm(19, (L, MLA_KV_LORA, MLA_HEADS * (MLA_NOPE + MLA_V)), MLA_KV_LORA ** -0.5),
        'swa_sink': nrm(21, (L, SWA_HEADS), 0.5),
        'gdn_conv_w': nrm(22, (L, GDN_CONV, GDN_CONV_CH), GDN_CONV ** -0.5),
        'gdn_a_log': jnp.log(jax.random.uniform(ks[23], (L, 2, GDN_HEADS), jnp.float32, minval=1.0, maxval=8.0)),
        'gdn_dt_bias': dt + jnp.log(-jnp.expm1(-dt)),
        'gdn_norm': 1.0 + nrm(24, (L, GDN_DV), 0.05),
        'w_out': nrm(25, (L, D_MIX, D_MODEL), D_MIX ** -0.5),
        'norm_ffn2': 1.0 + nrm(26, (L, D_MODEL), 0.05),
        'ffn2_w1': nrm(27, (L, D_MODEL, 2 * D_FF), D_MODEL ** -0.5),
        'ffn2_w2': nrm(28, (L, D_FF, D_MODEL), D_FF ** -0.5),
        'final_norm': 1.0 + nrm(29, (D_MODEL,), 0.05),
    }


def reference(x_prompt, x_sample, cache_mla_ckv, cache_mla_krope, cache_swa_k, cache_swa_v, state_gdn, c,
              c_ctx, w_ada, b_ada, norm_ffn1, ffn1_w1, ffn1_w2, norm_mix, w_in, mla_q_norm, mla_w_qb,
              mla_kv_norm, mla_w_kvb, swa_sink, gdn_conv_w, gdn_a_log, gdn_dt_bias, gdn_norm, w_out,
              norm_ffn2, ffn2_w1, ffn2_w2, final_norm):
    xp, xs = x_prompt, x_sample
    ctx_ckv, ctx_krope, ctx_sk, ctx_sv, ctx_st = [], [], [], [], []
    for l in range(DEPTH):
        lp = {
            'norm_ffn1': norm_ffn1[l], 'ffn1_w1': ffn1_w1[l], 'ffn1_w2': ffn1_w2[l],
            'norm_mix': norm_mix[l], 'w_in': w_in[l],
            'mla_q_norm': mla_q_norm[l], 'mla_w_qb': mla_w_qb[l],
            'mla_kv_norm': mla_kv_norm[l], 'mla_w_kvb': mla_w_kvb[l],
            'swa_sink': swa_sink[l], 'gdn_conv_w': gdn_conv_w[l],
            'gdn_a_log': gdn_a_log[l], 'gdn_dt_bias': gdn_dt_bias[l], 'gdn_norm': gdn_norm[l],
            'w_out': w_out[l], 'norm_ffn2': norm_ffn2[l], 'ffn2_w1': ffn2_w1[l], 'ffn2_w2': ffn2_w2[l],
        }
        mod_ctx = adaln_params(c_ctx[None, :], w_ada[l], b_ada[l])
        mod_lat = adaln_params(c, w_ada[l], b_ada[l])
        xp, (ckv_l, krope_l, sk_l, sv_l, st_l) = macaron_layer(
            xp, mod_ctx, lp, functools.partial(mixer_context, lp=lp))
        ctx_ckv.append(ckv_l)
        ctx_krope.append(krope_l)
        ctx_sk.append(sk_l)
        ctx_sv.append(sv_l)
        ctx_st.append(st_l)
        cache_l = (cache_mla_ckv[:, l], cache_mla_krope[:, l], cache_swa_k[:, l], cache_swa_v[:, l],
                   state_gdn[:, l])
        xs, _ = macaron_layer(xs, mod_lat, lp, functools.partial(mixer_latent, lp=lp, ctx=cache_l))
    y_prompt = rms_norm(xp, final_norm)
    y_sample = rms_norm(xs, final_norm)
    new_mla_ckv = jnp.stack(ctx_ckv, axis=1)
    new_mla_krope = jnp.stack(ctx_krope, axis=1)
    new_swa_k = jnp.stack(ctx_sk, axis=1)
    new_swa_v = jnp.stack(ctx_sv, axis=1)
    new_state_gdn = jnp.stack(ctx_st, axis=1).astype(x_prompt.dtype)
    return (y_prompt, y_sample, new_mla_ckv, new_mla_krope, new_swa_k, new_swa_v, new_state_gdn)
```

```cpp
#include <hip/hip_runtime.h>
#include <hip/hip_cooperative_groups.h>
#include <stdint.h>
#include <stdio.h>
namespace cg = cooperative_groups;

#ifndef MEGA
#define MEGA 1
#endif


typedef unsigned short bf16_t;
typedef short bf16x8 __attribute__((ext_vector_type(8)));
typedef float f32x4 __attribute__((ext_vector_type(4)));
typedef float f32x16 __attribute__((ext_vector_type(16)));
typedef unsigned u32x4 __attribute__((ext_vector_type(4)));
typedef unsigned u32x2 __attribute__((ext_vector_type(2)));

#define NTOK 8192
#define NCTX 4096
#define DM 1024
#define DFF 2816
#define UW 3584
#define LOG2E 1.4426950408889634f
#define LAS __attribute__((address_space(3)))
#define NEPS 1e-6f
#define SMEM_BYTES 74240

#define U_CQ 0
#define U_CKV 384
#define U_KR 640
#define U_SQ 672
#define U_SK 1184
#define U_SV 1312
#define U_GQKV 1440
#define U_GZ 2976
#define U_GATE 3488

constexpr size_t SZ_W1T = (size_t)5632 * 1024 * 2, SZ_W2T = (size_t)1024 * 2816 * 2, SZ_WINT = (size_t)3584 * 1024 * 2,
                 SZ_WQBT = (size_t)768 * 384 * 2, SZ_WKVBT = (size_t)1024 * 256 * 2, SZ_WOUTT = (size_t)1024 * 1536 * 2;
constexpr size_t WO_W1A = 0, WO_W2A = WO_W1A + SZ_W1T, WO_WIN = WO_W2A + SZ_W2T, WO_WQB = WO_WIN + SZ_WINT, WO_WKVB = WO_WQB + SZ_WQBT,
                 WO_WOUT = WO_WKVB + SZ_WKVBT, WO_W1B = WO_WOUT + SZ_WOUTT, WO_W2B = WO_W1B + SZ_W1T, LAYER_W = WO_W2B + SZ_W2T;
constexpr size_t OFF_CTRL = 0, OFF_MOD = 16384, OFF_W = OFF_MOD + (size_t)2 * 3 * 9216 * 4, OFF_H = OFF_W + 2 * LAYER_W,
                 OFF_CQN = OFF_H + (size_t)8192 * 1024 * 2, OFF_CKVA = OFF_CQN + (size_t)8192 * 384 * 2,
                 OFF_R1 = OFF_CKVA + (size_t)9216 * 256 * 2, SZ_R1 = (size_t)8192 * 3584 * 2,
                 OFF_QRAW = OFF_R1 + SZ_R1, OFF_KMLA = OFF_QRAW + (size_t)8192 * 768 * 2, OFF_VMLA = OFF_KMLA + (size_t)73728 * 96 * 2,
                 OFF_QSWA = OFF_VMLA + (size_t)73728 * 64 * 2, OFF_KSWA = OFF_QSWA + (size_t)8192 * 512 * 2,
                 OFF_VSWA = OFF_KSWA + (size_t)18432 * 64 * 2, OFF_GQ = OFF_VSWA + (size_t)18432 * 64 * 2,
                 OFF_GZ = OFF_GQ + (size_t)8192 * 512 * 2, OFF_GK = OFF_GZ + (size_t)8192 * 512 * 2, OFF_GV = OFF_GK + (size_t)8192 * 512 * 4,
                 OFF_GG = OFF_GV + (size_t)8192 * 512 * 4, OFF_GB = OFF_GG + (size_t)8192 * 8 * 4, OFF_GTOT = OFF_GB + (size_t)8192 * 8 * 4,
                 OFF_EGQ = OFF_GTOT + 4096, WS_TOTAL = OFF_EGQ + (size_t)1024 * 64 * 4;
constexpr size_t R1_U = 0, R1_KDT = (size_t)1024 * 16384, R1_WN = 2 * R1_KDT, R1_AI = 3 * R1_KDT;

#define OUT_Y 0
#define OUT_CKV 8388608
#define OUT_KROPE 10485760
#define OUT_SWAK 10747904
#define OUT_SWAV 11796480
#define OUT_STATE 12845056

struct Params {
    const float *x_prompt, *x_sample, *c_mla_ckv, *c_mla_krope, *c_swa_k, *c_swa_v, *state_gdn, *c, *c_ctx, *w_ada, *b_ada, *norm_ffn1,
        *ffn1_w1, *ffn1_w2, *norm_mix, *w_in, *mla_q_norm, *mla_w_qb, *mla_kv_norm, *mla_w_kvb, *swa_sink, *gdn_conv_w, *gdn_a_log,
        *gdn_dt_bias, *gdn_norm, *w_out, *norm_ffn2, *ffn2_w1, *ffn2_w2, *final_norm;
    float* out;
    char* ws;
};


#define GAS __attribute__((address_space(1)))
#define CAS __attribute__((address_space(4)))
__device__ __forceinline__ const float* kin(int byte_off) {
    const CAS char* ka = (const CAS char*)__builtin_amdgcn_kernarg_segment_ptr();
    unsigned z = 0; asm volatile("" : "+s"(z));
    const unsigned long long v = *(const CAS unsigned long long*)(ka + byte_off + z);
    return (const float*)(GAS const float*)v;
}
#define KIN(f) kin((int)__builtin_offsetof(Params, f))
__device__ __forceinline__ int ltid() { int t = threadIdx.x; asm volatile("" : "+v"(t)); return t; }
__device__ __forceinline__ float bf2f(bf16_t v) { return __uint_as_float(((unsigned)v) << 16); }
typedef float f32x2_t __attribute__((ext_vector_type(2)));
typedef __bf16 bf16x2_t __attribute__((ext_vector_type(2)));
__device__ __forceinline__ unsigned cvtpk(float lo, float hi) { f32x2_t v = {lo, hi}; bf16x2_t b = __builtin_convertvector(v, bf16x2_t); return __builtin_bit_cast(unsigned, b); }
__device__ __forceinline__ bf16_t f2bf(float f) { return (bf16_t)(cvtpk(f, 0.f) & 0xffffu); }
__device__ __forceinline__ bf16x8 pack8(float a0, float a1, float a2, float a3, float a4, float a5, float a6, float a7) {
    u32x4 w; w.x = cvtpk(a0, a1); w.y = cvtpk(a2, a3); w.z = cvtpk(a4, a5); w.w = cvtpk(a6, a7); return __builtin_bit_cast(bf16x8, w);
}
__device__ __forceinline__ bf16x8 ld2x8(const bf16_t* p0, const bf16_t* p1) {
    u32x2 a = *(const u32x2*)p0, b = *(const u32x2*)p1; u32x4 w; w.x = a.x; w.y = a.y; w.z = b.x; w.w = b.y; return __builtin_bit_cast(bf16x8, w);
}
__device__ __forceinline__ float shx(float v, int m, int lane) { return __int_as_float(__builtin_amdgcn_ds_bpermute((lane ^ m) << 2, __float_as_int(v))); }
__device__ __forceinline__ float wave_sum(float v, int lane) {
    v += shx(v, 32, lane); v += shx(v, 16, lane); v += shx(v, 8, lane); v += shx(v, 4, lane); v += shx(v, 2, lane); v += shx(v, 1, lane); return v;
}
__device__ __forceinline__ float siluf(float x) { return x * __builtin_amdgcn_rcpf(1.f + __expf(-x)); }
__device__ __forceinline__ int modrow(int tok) { return tok < NCTX ? 0 : 1 + ((tok - NCTX) >> 11); }
__device__ __forceinline__ int rowmap(int i, int hh) { return (i & 3) + 8 * (i >> 2) + 4 * hh; }
#define MFMA32(a, b, c) __builtin_amdgcn_mfma_f32_32x32x16_bf16(a, b, c, 0, 0, 0)
#define MFMA16(a, b, c) __builtin_amdgcn_mfma_f32_16x16x32_bf16(a, b, c, 0, 0, 0)

__device__ __forceinline__ void p0_ada(const Params& p, int it, char* smem) {
    const int tid = ltid(), l = it / 144, n0 = (it % 144) * 64, w = tid >> 6, lane = tid & 63;
    LAS float* s = (LAS float*)(LAS char*)smem;
    LAS float* red = s + 3072;
    for (int k = tid; k < 1024; k += 256) {
        s[k] = siluf(KIN(c_ctx)[k]); s[1024 + k] = siluf(KIN(c)[k]); s[2048 + k] = siluf(KIN(c)[1024 + k]);
    }
    __syncthreads();
    const float* wp = KIN(w_ada) + ((size_t)l * 1024 + w * 256) * 9216 + n0 + lane;
    float a0 = 0.f, a1 = 0.f, a2 = 0.f;
#pragma unroll 32
    for (int k = 0; k < 256; ++k) {
        const float wv = wp[(size_t)k * 9216]; const int kk = w * 256 + k;
        a0 += s[kk] * wv; a1 += s[1024 + kk] * wv; a2 += s[2048 + kk] * wv;
    }
    red[(w * 3 + 0) * 64 + lane] = a0; red[(w * 3 + 1) * 64 + lane] = a1; red[(w * 3 + 2) * 64 + lane] = a2;
    __syncthreads();
    if (tid < 192) {
        const int r = tid >> 6;
        const float v = red[(0 * 3 + r) * 64 + lane] + red[(1 * 3 + r) * 64 + lane] + red[(2 * 3 + r) * 64 + lane] + red[(3 * 3 + r) * 64 + lane];
        float* mod = (float*)(p.ws + OFF_MOD);
        mod[((size_t)l * 3 + r) * 9216 + n0 + lane] = v + KIN(b_ada)[(size_t)l * 9216 + n0 + lane];
    }
}

__device__ __forceinline__ void conv_desc(const Params& p, int l, int w, const float*& src, bf16_t*& dst, int& K, int& Nsrc, int& Ndst, int& Nvalid, int& mode) {
    char* wb = p.ws + OFF_W + (size_t)l * LAYER_W; mode = 0;
    switch (w) {
        case 0: src = KIN(ffn1_w1) + (size_t)l * 1024 * 5632; dst = (bf16_t*)(wb + WO_W1A); K = 1024; Nsrc = 5632; Ndst = 5632; Nvalid = 5632; mode = 1; break;
        case 1: src = KIN(ffn1_w2) + (size_t)l * 2816 * 1024; dst = (bf16_t*)(wb + WO_W2A); K = 2816; Nsrc = 1024; Ndst = 1024; Nvalid = 1024; break;
        case 2: src = KIN(w_in) + (size_t)l * 1024 * 3504; dst = (bf16_t*)(wb + WO_WIN); K = 1024; Nsrc = 3504; Ndst = 3584; Nvalid = 3504; break;
        case 3: src = KIN(mla_w_qb) + (size_t)l * 384 * 768; dst = (bf16_t*)(wb + WO_WQB); K = 384; Nsrc = 768; Ndst = 768; Nvalid = 768; break;
        case 4: src = KIN(mla_w_kvb) + (size_t)l * 256 * 1024; dst = (bf16_t*)(wb + WO_WKVB); K = 256; Nsrc = 1024; Ndst = 1024; Nvalid = 1024; break;
        case 5: src = KIN(w_out) + (size_t)l * 1536 * 1024; dst = (bf16_t*)(wb + WO_WOUT); K = 1536; Nsrc = 1024; Ndst = 1024; Nvalid = 1024; break;
        case 6: src = KIN(ffn2_w1) + (size_t)l * 1024 * 5632; dst = (bf16_t*)(wb + WO_W1B); K = 1024; Nsrc = 5632; Ndst = 5632; Nvalid = 5632; mode = 1; break;
        default: src = KIN(ffn2_w2) + (size_t)l * 2816 * 1024; dst = (bf16_t*)(wb + WO_W2B); K = 2816; Nsrc = 1024; Ndst = 1024; Nvalid = 1024; break;
    }
}
#define CONV_PER_LAYER 1416
__device__ __forceinline__ void p0_conv(const Params& p, int it, char* smem) {
    const int tid = ltid();
    const int l = it / CONV_PER_LAYER; int r = it % CONV_PER_LAYER;
    const int cnt[8] = {352, 176, 224, 24, 16, 96, 352, 176};
    int w = 0;
#pragma unroll
    for (int i = 0; i < 7; ++i) { if (w == i && r >= cnt[i]) { r -= cnt[i]; w = i + 1; } }
    const float* src; bf16_t* dst; int K, Nsrc, Ndst, Nvalid, mode;
    conv_desc(p, l, w, src, dst, K, Nsrc, Ndst, Nvalid, mode);
    const int kts = K >> 6, kg = (kts + 3) >> 2, nt = r / kg, kq = r % kg, k0 = kq * 256;
    const int ntl = (kts - 4 * kq) < 4 ? (kts - 4 * kq) : 4;
    LAS float* tile = (LAS float*)(LAS char*)smem;
    {
        const int rr = tid & 63, ks = tid >> 6;
        const int rd = nt * 64 + rr; int sc;
        if (mode == 1) { const int t = rd >> 7, q = rd & 127, wc = q >> 6, j = (q & 63) >> 4, i = q & 15; sc = (j & 1) * 2816 + t * 64 + wc * 32 + (j >> 1) * 16 + i; }
        else sc = rd;
        const bool ok = rd < Nvalid;
        const float* sp = src + (size_t)(k0 + ks) * Nsrc + (ok ? sc : 0);
        float v[4][16];
#pragma unroll
        for (int t = 0; t < 4; ++t)
#pragma unroll
            for (int e = 0; e < 16; ++e) v[t][e] = (ok && t < ntl) ? sp[(size_t)(64 * t + 4 * e) * Nsrc] : 0.f;
#pragma unroll
        for (int t = 0; t < 4; ++t)
#pragma unroll
            for (int e = 0; e < 16; ++e) tile[t * 4160 + (ks + 4 * e) * 65 + rr] = v[t][e];
    }
    __syncthreads();
    {
        const int rr = tid >> 2, kc = (tid & 3) * 16;
#pragma unroll
        for (int t = 0; t < 4; ++t) {
            if (t < ntl) {
                const LAS float* tl = tile + t * 4160;
                u32x4 w0, w1;
                w0.x = cvtpk(tl[(kc + 0) * 65 + rr], tl[(kc + 1) * 65 + rr]); w0.y = cvtpk(tl[(kc + 2) * 65 + rr], tl[(kc + 3) * 65 + rr]);
                w0.z = cvtpk(tl[(kc + 4) * 65 + rr], tl[(kc + 5) * 65 + rr]); w0.w = cvtpk(tl[(kc + 6) * 65 + rr], tl[(kc + 7) * 65 + rr]);
                w1.x = cvtpk(tl[(kc + 8) * 65 + rr], tl[(kc + 9) * 65 + rr]); w1.y = cvtpk(tl[(kc + 10) * 65 + rr], tl[(kc + 11) * 65 + rr]);
                w1.z = cvtpk(tl[(kc + 12) * 65 + rr], tl[(kc + 13) * 65 + rr]); w1.w = cvtpk(tl[(kc + 14) * 65 + rr], tl[(kc + 15) * 65 + rr]);
                bf16_t* d = dst + (size_t)(nt * 64 + rr) * K + k0 + 64 * t + kc;
                *(u32x4*)d = w0; *(u32x4*)(d + 8) = w1;
            }
        }
    }
}
__device__ __forceinline__ void p0_copy(const Params& p, int it) {
    const int tid = ltid();
    const size_t base = (size_t)it * 8192;
    const float* src = base < (size_t)4194304 ? KIN(x_prompt) + base : KIN(x_sample) + (base - 4194304);
    float* dst = p.out + OUT_Y + base;
#pragma unroll
    for (int i = 0; i < 8; ++i) *(f32x4*)(dst + (i * 256 + tid) * 4) = *(const f32x4*)(src + (i * 256 + tid) * 4);
}

__device__ __forceinline__ void normmod_item(const Params& p, int l, int which  , int it) {
    const int tid = ltid(), w = tid >> 6, lane = tid & 63, row0 = it * 16 + w * 4;
    float* x = p.out + OUT_Y + (size_t)row0 * 1024;
    f32x4 v[4][4]; float ss[4];
#pragma unroll
    for (int j = 0; j < 4; ++j)
#pragma unroll
        for (int i = 0; i < 4; ++i) v[j][i] = *(const f32x4*)(x + j * 1024 + (i * 64 + lane) * 4);
#pragma unroll
    for (int j = 0; j < 4; ++j) {
        float a = 0.f;
#pragma unroll
        for (int i = 0; i < 4; ++i) a += v[j][i][0] * v[j][i][0] + v[j][i][1] * v[j][i][1] + v[j][i][2] * v[j][i][2] + v[j][i][3] * v[j][i][3];
        ss[j] = a;
    }
#pragma unroll
    for (int m = 32; m >= 1; m >>= 1)
#pragma unroll
        for (int j = 0; j < 4; ++j) ss[j] += shx(ss[j], m, lane);
    if (which == 3) {
        const float* fn = KIN(final_norm);
#pragma unroll
        for (int i = 0; i < 4; ++i) {
            const int c = (i * 64 + lane) * 4; const f32x4 g = *(const f32x4*)(fn + c);
#pragma unroll
            for (int j = 0; j < 4; ++j) { const float rs = rsqrtf(ss[j] * (1.f / 1024.f) + NEPS); *(f32x4*)(x + j * 1024 + c) = v[j][i] * rs * g; }
        }
        return;
    }
    const float* gain = (which == 0 ? KIN(norm_ffn1) : which == 1 ? KIN(norm_mix) : KIN(norm_ffn2)) + (size_t)l * 1024;
    const float* mod = (const float*)(p.ws + OFF_MOD) + ((size_t)l * 3 + modrow(row0)) * 9216 + which * 3072;
    bf16_t* h = (bf16_t*)(p.ws + OFF_H) + (size_t)row0 * 1024;
#pragma unroll
    for (int i = 0; i < 4; ++i) {
        const int c = (i * 64 + lane) * 4; const f32x4 g = *(const f32x4*)(gain + c), sh = *(const f32x4*)(mod + c), sc = *(const f32x4*)(mod + 1024 + c);
#pragma unroll
        for (int j = 0; j < 4; ++j) {
            const float rs = rsqrtf(ss[j] * (1.f / 1024.f) + NEPS);
            const f32x4 o = v[j][i] * rs * g * (sc + 1.f) + sh; u32x2 pk; pk.x = cvtpk(o[0], o[1]); pk.y = cvtpk(o[2], o[3]); *(u32x2*)(h + j * 1024 + c) = pk;
        }
    }
}

enum { EPI_SWIGLU = 0, EPI_RESID = 1, EPI_BF16 = 2, EPI_KV = 3 };
struct EpiArgs { void* out; int ld; const float* gate; float scale; };

template <int EPI>
__device__ __forceinline__ void gemm_tile(const bf16_t* __restrict__ A, int lda, const bf16_t* __restrict__ Bt, int K, int tm, int tn, const EpiArgs e, char* smem) {
    const int tid = ltid(), wave = tid >> 6, lane = tid & 63, wr = wave >> 1, wc = wave & 1, fr = lane & 15, fq = lane >> 4;
    const int m0 = tm * 128, n0 = tn * 128;
    f32x4 acc[4][4];
#pragma unroll
    for (int i = 0; i < 4; ++i)
#pragma unroll
        for (int j = 0; j < 4; ++j) acc[i][j] = (f32x4){0.f, 0.f, 0.f, 0.f};
    LAS char* ls = (LAS char*)smem;
    const int lr = lane >> 3, sch = (lane & 7) ^ lr;
    const bf16_t* ga = A + (size_t)(m0 + wave * 32 + lr) * lda + sch * 8;
    const bf16_t* gb = Bt + (size_t)(n0 + wave * 32 + lr) * K + sch * 8;
    const int nk = K >> 6;
#define GEMM_STAGE(buf, k0) do { _Pragma("unroll") for (int _i = 0; _i < 4; ++_i) { \
        __builtin_amdgcn_global_load_lds((const unsigned*)(ga + (size_t)_i * 8 * lda + (k0)), (LAS unsigned*)(ls + (buf) * 32768 + wave * 4096 + _i * 1024), 16, 0, 0); \
        __builtin_amdgcn_global_load_lds((const unsigned*)(gb + (size_t)_i * 8 * K + (k0)), (LAS unsigned*)(ls + (buf) * 32768 + 16384 + wave * 4096 + _i * 1024), 16, 0, 0); } } while (0)
    GEMM_STAGE(0, 0);
    __syncthreads();
    for (int kt = 0; kt < nk; ++kt) {
        const int cur = kt & 1;
        if (kt + 1 < nk) GEMM_STAGE(cur ^ 1, (kt + 1) * 64);
        const LAS char* sA = ls + cur * 32768; const LAS char* sB = sA + 16384;
        bf16x8 af[2][4], bfr[2][4];
#pragma unroll
        for (int ks = 0; ks < 2; ++ks)
#pragma unroll
            for (int i = 0; i < 4; ++i) {
                const int ar = wr * 64 + i * 16 + fr, br = wc * 64 + i * 16 + fr, ch = ks * 4 + fq;
                af[ks][i] = *(const LAS bf16x8*)(sA + ar * 128 + ((ch ^ (ar & 7)) << 4));
                bfr[ks][i] = *(const LAS bf16x8*)(sB + br * 128 + ((ch ^ (br & 7)) << 4));
            }
        __builtin_amdgcn_s_setprio(1);
#pragma unroll
        for (int ks = 0; ks < 2; ++ks)
#pragma unroll
            for (int i = 0; i < 4; ++i)
#pragma unroll
                for (int j = 0; j < 4; ++j) acc[i][j] = MFMA16(bfr[ks][j], af[ks][i], acc[i][j]);
        __builtin_amdgcn_s_setprio(0);
        __syncthreads();
    }
#undef GEMM_STAGE
#pragma unroll
    for (int i = 0; i < 4; ++i) {
        const int row = m0 + wr * 64 + i * 16 + fr;
        asm volatile("" ::: "memory");
        if (EPI == EPI_SWIGLU) {
            bf16_t* o = (bf16_t*)e.out + (size_t)row * DFF + tn * 64 + wc * 32 + 4 * fq;
#pragma unroll
            for (int pp = 0; pp < 2; ++pp) {
                const f32x4 g = acc[i][2 * pp], u = acc[i][2 * pp + 1];
                u32x2 pk; pk.x = cvtpk(siluf(g[0]) * u[0], siluf(g[1]) * u[1]); pk.y = cvtpk(siluf(g[2]) * u[2], siluf(g[3]) * u[3]);
                *(u32x2*)(o + pp * 16) = pk;
            }
        } else if (EPI == EPI_RESID) {
            float* x = (float*)e.out + (size_t)row * 1024;
            const float* g = e.gate + (size_t)modrow(row) * 9216;
#pragma unroll
            for (int j = 0; j < 4; ++j) {
                const int col = n0 + wc * 64 + j * 16 + 4 * fq;
                const f32x4 gv = *(const f32x4*)(g + col); f32x4 xv = *(const f32x4*)(x + col);
                xv = xv + gv * acc[i][j] * e.scale; *(f32x4*)(x + col) = xv;
            }
        } else if (EPI == EPI_BF16) {
            bf16_t* o = (bf16_t*)e.out + (size_t)row * e.ld;
#pragma unroll
            for (int j = 0; j < 4; ++j) {
                const int col = n0 + wc * 64 + j * 16 + 4 * fq;
                u32x2 pk; pk.x = cvtpk(acc[i][j][0], acc[i][j][1]); pk.y = cvtpk(acc[i][j][2], acc[i][j][3]); *(u32x2*)(o + col) = pk;
            }
        } else {
            size_t prow;
            int hstride;
            if (row < 4096) { prow = (size_t)(row >> 8) * 8 * 256 + (row & 255); hstride = 256; }
            else if (row < 8192) { const int r2 = row - 4096; prow = 32768 + (size_t)(r2 >> 11) * 8 * 2560 + (r2 & 2047); hstride = 2560; }
            else { const int r2 = row - 8192; prow = 32768 + (size_t)(r2 >> 9) * 8 * 2560 + 2048 + (r2 & 511); hstride = 2560; }
            bf16_t* Kp = (bf16_t*)(((Params*)e.out)->ws + OFF_KMLA); bf16_t* Vp = (bf16_t*)(((Params*)e.out)->ws + OFF_VMLA);
#pragma unroll
            for (int j = 0; j < 4; ++j) {
                const int col = n0 + wc * 64 + j * 16 + 4 * fq; const int hd = col >> 7, wi = col & 127;
                u32x2 pk; pk.x = cvtpk(acc[i][j][0], acc[i][j][1]); pk.y = cvtpk(acc[i][j][2], acc[i][j][3]);
                const size_t pr = prow + (size_t)hd * hstride;
                if (wi < 64) *(u32x2*)(Kp + pr * 96 + wi) = pk; else *(u32x2*)(Vp + pr * 64 + (wi - 64)) = pk;
            }
        }
    }
}

__device__ __forceinline__ void f1_token(const Params& p, int l, int tok, int lane) {
    const bf16_t* ur = (const bf16_t*)(p.ws + OFF_R1) + (size_t)tok * UW;
    const bool lat = tok >= NCTX;
    int b, s, T;
    if (!lat) { b = tok >> 8; s = tok & 255; T = 256; } else { b = (tok - NCTX) >> 11; s = (tok - NCTX) & 2047; T = 2048; }
    const float prow_ = (float)(s >> 6), pcol_ = (float)(s & 63);
    bf16_t* Kmla = (bf16_t*)(p.ws + OFF_KMLA);
    bf16_t pl_cq[6], pl_kv[4], pl_kr[2], pl_sq[8], pl_sk[2], pl_sv[2], pl_gz[8], pl_gt[2];
    {
        const int l16 = lane & 15, ksec = l16 >> 3, kj = l16 & 7;
#pragma unroll
        for (int i = 0; i < 6; ++i) pl_cq[i] = ur[U_CQ + lane + 64 * i];
#pragma unroll
        for (int i = 0; i < 4; ++i) pl_kv[i] = ur[U_CKV + lane + 64 * i];
        pl_kr[0] = ur[U_KR + ksec * 16 + kj]; pl_kr[1] = ur[U_KR + ksec * 16 + kj + 8];
#pragma unroll
        for (int i = 0; i < 4; ++i) { const int P = lane + 64 * i, head = P >> 5, pi = P & 31, sec = pi >> 4, j = pi & 15, base = head * 64 + sec * 32 + j; pl_sq[2 * i] = ur[U_SQ + base]; pl_sq[2 * i + 1] = ur[U_SQ + base + 16]; }
        { const int kvh = lane >> 5, pi = lane & 31, sec = pi >> 4, j = pi & 15, base = kvh * 64 + sec * 32 + j; pl_sk[0] = ur[U_SK + base]; pl_sk[1] = ur[U_SK + base + 16]; }
        pl_sv[0] = ur[U_SV + lane]; pl_sv[1] = ur[U_SV + 64 + lane];
#pragma unroll
        for (int i = 0; i < 8; ++i) pl_gz[i] = ur[U_GZ + lane + 64 * i];
        pl_gt[0] = ur[U_GATE + (lane & 7)]; pl_gt[1] = ur[U_GATE + 8 + (lane & 7)];
    }
    {
        float v[6]; float ss = 0.f;
#pragma unroll
        for (int i = 0; i < 6; ++i) { v[i] = bf2f(pl_cq[i]); ss += v[i] * v[i]; }
        ss = wave_sum(ss, lane); const float rs = rsqrtf(ss * (1.f / 384.f) + NEPS);
        bf16_t* o = (bf16_t*)(p.ws + OFF_CQN) + (size_t)tok * 384;
#pragma unroll
        for (int i = 0; i < 6; ++i) o[lane + 64 * i] = f2bf(v[i] * rs * KIN(mla_q_norm)[l * 384 + lane + 64 * i]);
    }
    {
        float v[4]; float ss = 0.f;
#pragma unroll
        for (int i = 0; i < 4; ++i) { v[i] = bf2f(pl_kv[i]); ss += v[i] * v[i]; }
        ss = wave_sum(ss, lane); const float rs = rsqrtf(ss * (1.f / 256.f) + NEPS);
        bf16_t* o = (bf16_t*)(p.ws + OFF_CKVA) + (size_t)tok * 256;
#pragma unroll
        for (int i = 0; i < 4; ++i) {
            const float val = v[i] * rs * KIN(mla_kv_norm)[l * 256 + lane + 64 * i];
            o[lane + 64 * i] = f2bf(val);
            if (!lat) p.out[OUT_CKV + ((size_t)(b * 2 + l) * 256 + s) * 256 + lane + 64 * i] = val;
        }
    }
    if (lane < 16) {
        const int sec = lane >> 3, j = lane & 7;
        float a = bf2f(pl_kr[0]), bb = bf2f(pl_kr[1]);
        if (lat) {
            const float ang = (sec ? pcol_ : prow_) * exp2f(-(float)j * 1.6609640474f);
            const float cs = __cosf(ang), sn = __sinf(ang);
            const float a2 = a * cs - bb * sn, b2 = bb * cs + a * sn; a = a2; bb = b2;
        } else {
            float* o = p.out + OUT_KROPE + ((size_t)(b * 2 + l) * 256 + s) * 32 + sec * 16 + j; o[0] = a; o[8] = bb;
        }
        const bf16_t ab = f2bf(a), bbb = f2bf(bb);
#pragma unroll
        for (int h = 0; h < 8; ++h) {
            const size_t pr = lat ? 32768 + (size_t)(b * 8 + h) * 2560 + s : (size_t)(b * 8 + h) * 256 + s;
            Kmla[pr * 96 + 64 + sec * 16 + j] = ab; Kmla[pr * 96 + 64 + sec * 16 + j + 8] = bbb;
        }
    }
    {
        bf16_t* Q = (bf16_t*)(p.ws + OFF_QSWA) + (size_t)tok * 512;
#pragma unroll
        for (int i = 0; i < 4; ++i) {
            const int P = lane + 64 * i, head = P >> 5, pi = P & 31, sec = pi >> 4, j = pi & 15, base = head * 64 + sec * 32 + j;
            float a = bf2f(pl_sq[2 * i]), bb = bf2f(pl_sq[2 * i + 1]);
            if (lat) {
                const float ang = (sec ? pcol_ : prow_) * exp2f(-(float)j * 0.830482024f);
                const float cs = __cosf(ang), sn = __sinf(ang);
                const float a2 = a * cs - bb * sn, b2 = bb * cs + a * sn; a = a2; bb = b2;
            }
            Q[base] = f2bf(a); Q[base + 16] = f2bf(bb);
        }
    }
    {
        const int kvh = lane >> 5, pi = lane & 31, sec = pi >> 4, j = pi & 15, base = kvh * 64 + sec * 32 + j;
        float a = bf2f(pl_sk[0]), bb = bf2f(pl_sk[1]);
        if (lat) {
            const float ang = (sec ? pcol_ : prow_) * exp2f(-(float)j * 0.830482024f);
            const float cs = __cosf(ang), sn = __sinf(ang);
            const float a2 = a * cs - bb * sn, b2 = bb * cs + a * sn; a = a2; bb = b2;
        } else {
            float* o = p.out + OUT_SWAK + (((size_t)(b * 2 + l) * 256 + s) * 2 + kvh) * 64 + sec * 32 + j; o[0] = a; o[16] = bb;
        }
        const size_t pr = lat ? 8192 + (size_t)(b * 2 + kvh) * 2560 + s : (size_t)(b * 2 + kvh) * 256 + s;
        bf16_t* Kp = (bf16_t*)(p.ws + OFF_KSWA) + pr * 64 + sec * 32 + j; Kp[0] = f2bf(a); Kp[16] = f2bf(bb);
    }
#pragma unroll
    for (int kvh = 0; kvh < 2; ++kvh) {
        const float v = bf2f(pl_sv[kvh]);
        const size_t pr = lat ? 8192 + (size_t)(b * 2 + kvh) * 2560 + s : (size_t)(b * 2 + kvh) * 256 + s;
        ((bf16_t*)(p.ws + OFF_VSWA))[pr * 64 + lane] = f2bf(v);
        if (!lat) p.out[OUT_SWAV + (((size_t)(b * 2 + l) * 256 + s) * 2 + kvh) * 64 + lane] = v;
    }
    {
        bf16_t* gz = (bf16_t*)(p.ws + OFF_GZ) + (size_t)tok * 512;
#pragma unroll
        for (int i = 0; i < 8; ++i) gz[lane + 64 * i] = pl_gz[i];
    }
    if (lane < 8) {
        const float ga = bf2f(pl_gt[0]), gb = bf2f(pl_gt[1]);
        const float xx = ga + KIN(gdn_dt_bias)[l * 8 + lane];
        const float sp = xx > 20.f ? xx : __logf(1.f + __expf(xx));
        ((float*)(p.ws + OFF_GG))[(size_t)tok * 8 + lane] = -__expf(KIN(gdn_a_log)[l * 8 + lane]) * sp;
        ((float*)(p.ws + OFF_GB))[(size_t)tok * 8 + lane] = 1.f / (1.f + __expf(-gb));
    }
}
__device__ __forceinline__ void f1_conv(const Params& p, int l, int blk, int wave, int lane) {
    const int tok0 = blk * 16;
    const bool lat = tok0 >= NCTX;
    const int s0 = lat ? ((tok0 - NCTX) & 2047) : (tok0 & 255), T = lat ? 2048 : 256;
    const bf16_t* ub = (const bf16_t*)(p.ws + OFF_R1) + (size_t)tok0 * UW + U_GQKV;
    const float* cw = KIN(gdn_conv_w) + (size_t)l * 5 * 1536;
    bf16_t* gq = (bf16_t*)(p.ws + OFF_GQ) + (size_t)tok0 * 512;
    float* gk = (float*)(p.ws + OFF_GK) + (size_t)tok0 * 512;
    float* gv = (float*)(p.ws + OFF_GV) + (size_t)tok0 * 512;
    for (int hi = 0; hi < 3; ++hi) {
        const int head = wave + 4 * hi, ch0 = head * 128 + lane, ch1 = ch0 + 64;
        float w0[5], w1[5], x0[5], x1[5];
#pragma unroll
        for (int jj = 0; jj < 5; ++jj) { w0[jj] = cw[jj * 1536 + ch0]; w1[jj] = cw[jj * 1536 + ch1]; }
#pragma unroll
        for (int jj = 0; jj < 4; ++jj) {
            const int sp = s0 + jj - 2; const bool ok = sp >= 0 && sp < T;
            x0[jj] = ok ? bf2f(ub[(ptrdiff_t)(jj - 2) * UW + ch0]) : 0.f; x1[jj] = ok ? bf2f(ub[(ptrdiff_t)(jj - 2) * UW + ch1]) : 0.f;
        }
        float y0[16], y1[16], ss[16];
#pragma unroll
        for (int t = 0; t < 16; ++t) {
            const int sp = s0 + t + 2; const bool ok = sp < T;
            x0[(t + 4) % 5] = ok ? bf2f(ub[(ptrdiff_t)(t + 2) * UW + ch0]) : 0.f; x1[(t + 4) % 5] = ok ? bf2f(ub[(ptrdiff_t)(t + 2) * UW + ch1]) : 0.f;
            float a0 = 0.f, a1 = 0.f;
#pragma unroll
            for (int jj = 0; jj < 5; ++jj) { a0 += w0[jj] * x0[(t + jj) % 5]; a1 += w1[jj] * x1[(t + jj) % 5]; }
            y0[t] = siluf(a0); y1[t] = siluf(a1); ss[t] = y0[t] * y0[t] + y1[t] * y1[t];
        }
        if (head < 8) {
#pragma unroll
            for (int m = 32; m >= 1; m >>= 1)
#pragma unroll
                for (int t = 0; t < 16; ++t) ss[t] += shx(ss[t], m, lane);
#pragma unroll
            for (int t = 0; t < 16; ++t) { const float rs = rsqrtf(ss[t] + 1e-6f); y0[t] *= rs; y1[t] *= rs; }
        }
#pragma unroll
        for (int t = 0; t < 16; ++t) {
            if (head < 4) { gq[t * 512 + ch0] = f2bf(y0[t]); gq[t * 512 + ch1] = f2bf(y1[t]); }
            else if (head < 8) { gk[t * 512 + ch0 - 512] = y0[t]; gk[t * 512 + ch1 - 512] = y1[t]; }
            else { gv[t * 512 + ch0 - 1024] = y0[t]; gv[t * 512 + ch1 - 1024] = y1[t]; }
        }
    }
}
__device__ __forceinline__ void f1_cache(const Params& p, int l, int idx, int lane) {
    const int b = idx >> 9, s = idx & 511;
    const size_t cb = (size_t)(b * 2 + l) * 512 + s;
    bf16_t* o = (bf16_t*)(p.ws + OFF_CKVA) + (size_t)(8192 + idx) * 256;
#pragma unroll
    for (int i = 0; i < 4; ++i) o[lane + 64 * i] = f2bf(KIN(c_mla_ckv)[cb * 256 + lane + 64 * i]);
    if (lane < 32) {
        const bf16_t v = f2bf(KIN(c_mla_krope)[cb * 32 + lane]);
#pragma unroll
        for (int h = 0; h < 8; ++h) ((bf16_t*)(p.ws + OFF_KMLA))[(32768 + (size_t)(b * 8 + h) * 2560 + 2048 + s) * 96 + 64 + lane] = v;
    }
#pragma unroll
    for (int kvh = 0; kvh < 2; ++kvh) {
        const size_t pr = 8192 + (size_t)(b * 2 + kvh) * 2560 + 2048 + s;
        ((bf16_t*)(p.ws + OFF_KSWA))[pr * 64 + lane] = f2bf(KIN(c_swa_k)[(cb * 2 + kvh) * 64 + lane]);
        ((bf16_t*)(p.ws + OFF_VSWA))[pr * 64 + lane] = f2bf(KIN(c_swa_v)[(cb * 2 + kvh) * 64 + lane]);
    }
}

__device__ __forceinline__ void cid_decode(int slot, int& R0, int& T, int& n) {
    if (slot < 64) { R0 = (slot >> 2) * 256; T = 256; n = slot & 3; } else { const int s2 = slot - 64; R0 = NCTX + (s2 >> 5) * 2048; T = 2048; n = s2 & 31; }
}
__device__ __forceinline__ void gdn_prep(const Params& p, int cid, char* smem) {
    const int tid = ltid(), h = cid & 3, slot = (cid >> 2) & 127, dir = cid >> 9;
    int R0, T, n; cid_decode(slot, R0, T, n);
    const int tbase = dir ? R0 + T - 1 - 64 * n : R0 + 64 * n, tstep = dir ? -1 : 1;
    LAS float* s_gc = (LAS float*)(LAS char*)smem; LAS float* s_beta = s_gc + 64; LAS float* s_eg = s_gc + 128;
    LAS float* s_L = s_gc + 192; LAS float* s_q = s_L + 4096; LAS float* s_k = s_q + 64 * 68;
    const bf16_t* gq = (const bf16_t*)(p.ws + OFF_GQ); const float* gk = (const float*)(p.ws + OFF_GK); const float* gv = (const float*)(p.ws + OFF_GV);
    if (tid < 64) {
        const int row = tbase + tstep * tid;
        float g = ((const float*)(p.ws + OFF_GG))[(size_t)row * 8 + dir * 4 + h];
        const float be = ((const float*)(p.ws + OFF_GB))[(size_t)row * 8 + dir * 4 + h];
#pragma unroll
        for (int d = 1; d < 64; d <<= 1) { const float t = __int_as_float(__builtin_amdgcn_ds_bpermute(((tid - d) & 63) << 2, __float_as_int(g))); if (tid >= d) g += t; }
        s_gc[tid] = g; s_beta[tid] = be; s_eg[tid] = __expf(g);
    }
    LAS char* lsb = (LAS char*)smem;
    constexpr int TQ = 17152, TST = 272, TKH = TQ + 64 * TST, TKL = TKH + 64 * TST;
    __syncthreads();
#pragma unroll
    for (int i = 0; i < 4; ++i) {
        const int c = tid + 256 * i, row = c >> 4, ch = c & 15; const size_t tok = (size_t)(tbase + tstep * row);
        *(LAS u32x4*)(lsb + TQ + row * TST + ch * 16) = *(const u32x4*)(gq + tok * 512 + h * 128 + ch * 8);
        const f32x4 k0 = *(const f32x4*)(gk + tok * 512 + h * 128 + ch * 8), k1 = *(const f32x4*)(gk + tok * 512 + h * 128 + ch * 8 + 4);
        u32x4 wh, wl;
        wh.x = cvtpk(k0[0], k0[1]); wh.y = cvtpk(k0[2], k0[3]); wh.z = cvtpk(k1[0], k1[1]); wh.w = cvtpk(k1[2], k1[3]);
        wl.x = cvtpk(k0[0] - __uint_as_float(wh.x << 16), k0[1] - __uint_as_float(wh.x & 0xffff0000u));
        wl.y = cvtpk(k0[2] - __uint_as_float(wh.y << 16), k0[3] - __uint_as_float(wh.y & 0xffff0000u));
        wl.z = cvtpk(k1[0] - __uint_as_float(wh.z << 16), k1[1] - __uint_as_float(wh.z & 0xffff0000u));
        wl.w = cvtpk(k1[2] - __uint_as_float(wh.w << 16), k1[3] - __uint_as_float(wh.w & 0xffff0000u));
        *(LAS u32x4*)(lsb + TKH + row * TST + ch * 16) = wh; *(LAS u32x4*)(lsb + TKL + row * TST + ch * 16) = wl;
    }
    __syncthreads();
    {
        const int wave = tid >> 6, lane = tid & 63, r = lane & 31, hh = lane >> 5, ti = wave >> 1, tj = wave & 1;
        f32x16 akk, aqk;
#pragma unroll
        for (int i = 0; i < 16; ++i) { akk[i] = 0.f; aqk[i] = 0.f; }
        const LAS char* ra = lsb + (32 * ti + r) * TST + 16 * hh; const LAS char* rb = lsb + (32 * tj + r) * TST + 16 * hh;
#pragma unroll
        for (int s8 = 0; s8 < 8; ++s8) {
            const bf16x8 akh = *(const LAS bf16x8*)(ra + TKH + 32 * s8), akl = *(const LAS bf16x8*)(ra + TKL + 32 * s8), aq = *(const LAS bf16x8*)(ra + TQ + 32 * s8);
            const bf16x8 bkh = *(const LAS bf16x8*)(rb + TKH + 32 * s8), bkl = *(const LAS bf16x8*)(rb + TKL + 32 * s8);
            akk = MFMA32(akh, bkh, akk); akk = MFMA32(akh, bkl, akk); akk = MFMA32(akl, bkh, akk);
            aqk = MFMA32(aq, bkh, aqk); aqk = MFMA32(aq, bkl, aqk);
        }
        const float qscale = 0.08838834764831845f;
        bf16_t* Ai = (bf16_t*)(p.ws + OFF_R1 + R1_AI) + (size_t)cid * 4096;
        const int j = 32 * tj + r; const float gcj = s_gc[j];
#pragma unroll
        for (int idx = 0; idx < 16; ++idx) {
            const int i = 32 * ti + rowmap(idx, hh);
            const float dec = (i >= j) ? __expf(s_gc[i] - gcj) : 0.f;
            s_L[i * 64 + j] = (i > j) ? s_beta[i] * akk[idx] * dec : 0.f;
            Ai[i * 64 + j] = f2bf(aqk[idx] * qscale * dec);
        }
    }
    __syncthreads();
    {
        const int c = tid;
        LAS float* xs = s_L + 4096;
        const float* src = (c < 128) ? (gv + h * 128 + c) : (gk + h * 128 + c - 128);
        bf16_t* Uo = (bf16_t*)(p.ws + OFF_R1 + R1_U) + (size_t)cid * 8192 + (c & 127) * 64;
        bf16_t* Wo = (bf16_t*)(p.ws + OFF_R1 + R1_WN) + (size_t)cid * 8192 + (c & 127);
#pragma unroll 1
        for (int I = 0; I < 4; ++I) {
            float xr[16];
#pragma unroll
            for (int rr = 0; rr < 16; ++rr) {
                const int i = 16 * I + rr;
                const float sc = (c < 128) ? s_beta[i] : s_beta[i] * s_eg[i];
                xr[rr] = sc * src[(size_t)(tbase + tstep * i) * 512];
            }
#pragma unroll 1
            for (int j4 = 0; j4 < 4 * I; ++j4) {
                const float xp0 = xs[(4 * j4) * 256 + c], xp1 = xs[(4 * j4 + 1) * 256 + c], xp2 = xs[(4 * j4 + 2) * 256 + c], xp3 = xs[(4 * j4 + 3) * 256 + c];
#pragma unroll
                for (int rr = 0; rr < 16; ++rr) {
                    const f32x4 Lv = *(const LAS f32x4*)(s_L + (16 * I + rr) * 64 + 4 * j4);
                    xr[rr] -= (Lv[0] * xp0 + Lv[2] * xp2) + (Lv[1] * xp1 + Lv[3] * xp3);
                }
            }
#pragma unroll
            for (int rr = 1; rr < 16; ++rr) {
                float a0 = 0.f, a1 = 0.f;
#pragma unroll
                for (int j4 = 0; j4 < (rr + 3) / 4; ++j4) {
                    const f32x4 Lv = *(const LAS f32x4*)(s_L + (16 * I + rr) * 64 + 16 * I + 4 * j4);
                    a0 += Lv[0] * xr[4 * j4] + Lv[2] * xr[4 * j4 + 2];
                    a1 += Lv[1] * xr[4 * j4 + 1] + Lv[3] * xr[4 * j4 + 3];
                }
                xr[rr] -= (a0 + a1);
            }
            if (I < 3) {
#pragma unroll
                for (int rr = 0; rr < 16; ++rr) xs[(16 * I + rr) * 256 + c] = xr[rr];
            }
            if (c < 128) {
                u32x4 w0, w1;
                w0.x = cvtpk(xr[0], xr[1]); w0.y = cvtpk(xr[2], xr[3]); w0.z = cvtpk(xr[4], xr[5]); w0.w = cvtpk(xr[6], xr[7]);
                w1.x = cvtpk(xr[8], xr[9]); w1.y = cvtpk(xr[10], xr[11]); w1.z = cvtpk(xr[12], xr[13]); w1.w = cvtpk(xr[14], xr[15]);
                *(u32x4*)(Uo + 16 * I) = w0; *(u32x4*)(Uo + 16 * I + 8) = w1;
            } else {
#pragma unroll
                for (int rr = 0; rr < 16; ++rr) Wo[(16 * I + rr) * 128] = f2bf(-xr[rr]);
            }
        }
    }
    const float gl = s_gc[63];
    bf16_t* KdT = (bf16_t*)(p.ws + OFF_R1 + R1_KDT) + (size_t)cid * 8192;
#pragma unroll
    for (int it = 0; it < 8; ++it) {
        const int w = tid + 256 * it, d = w & 127, p4 = w >> 7; float v[4];
#pragma unroll
        for (int e = 0; e < 4; ++e) { const int pp = 4 * p4 + e; v[e] = gk[(size_t)(tbase + tstep * pp) * 512 + h * 128 + d] * __expf(gl - s_gc[pp]); }
        u32x2 pk; pk.x = cvtpk(v[0], v[1]); pk.y = cvtpk(v[2], v[3]); *(u32x2*)(KdT + d * 64 + 4 * p4) = pk;
    }
    if (tid < 64) ((float*)(p.ws + OFF_EGQ))[(size_t)cid * 64 + tid] = 0.08838834764831845f * s_eg[tid];
    if (tid == 0) ((float*)(p.ws + OFF_GTOT))[cid] = __expf(gl);
}

#define SC_RW 0
#define SC_RQ 16384
#define SC_RK 32768
#define SC_RA 49152
#define SC_RU 57344
#define SC_RE 73728
__device__ __forceinline__ bf16x8 lds2x8(const LAS char* p0) { u32x2 a = *(const LAS u32x2*)p0, b = *(const LAS u32x2*)(p0 + 16); u32x4 w; w.x = a.x; w.y = a.y; w.z = b.x; w.w = b.y; return __builtin_bit_cast(bf16x8, w); }
__device__ __forceinline__ bf16x8 lds_sw(const LAS char* rowbase, int m16, int c) {
    const int o = m16 ^ (c << 4);
    u32x2 a = *(const LAS u32x2*)(rowbase + o), b = *(const LAS u32x2*)(rowbase + (o ^ 16)); u32x4 w; w.x = a.x; w.y = a.y; w.z = b.x; w.w = b.y; return __builtin_bit_cast(bf16x8, w);
}
__device__ __forceinline__ void gdn_scan(const Params& p, int l, int item, char* smem) {
    const int tid = ltid(), wave = tid >> 6, lane = tid & 63, r = lane & 31, hh = lane >> 5, dv = wave * 32 + r;
    LAS char* ls = (LAS char*)smem;
    const int h = item & 3, dir = (item >> 2) & 1, sqi = item >> 3;
    int R0, T, nch, slot0;
    if (sqi >= 2) { const int b = sqi - 2; R0 = b * 256; T = 256; nch = 4; slot0 = b * 4; } else { R0 = NCTX + sqi * 2048; T = 2048; nch = 32; slot0 = 64 + sqi * 32; }
    const unsigned loU = (unsigned)(4 * hh * 128 + dv), loO = (unsigned)((dir ? 4 - 4 * hh : 4 * hh) * 512 + dv);
    const bf16_t* gq = (const bf16_t*)(p.ws + OFF_GQ) + h * 128;
    float* odir = (float*)(p.ws + OFF_GK) + (size_t)dir * 8192 * 512 + h * 128;
    const int ra = lane >> 4, ca = lane & 15, rb = lane >> 3, cb = lane & 7;
    auto dma_g1 = [&](int n) {
        const int cid = (dir * 128 + slot0 + n) * 4 + h;
        const char* Wn = p.ws + OFF_R1 + R1_WN + (size_t)cid * 16384; const char* UT = p.ws + OFF_R1 + R1_U + (size_t)cid * 16384;
#pragma unroll
        for (int i = 0; i < 4; ++i) {
            const int pc = wave * 4 + i, rowa = 4 * pc + ra, rowb = 8 * pc + rb;
            __builtin_amdgcn_global_load_lds((const unsigned*)(Wn + rowa * 256 + ((ca ^ (rowa & 15)) << 4)), (LAS unsigned*)(ls + SC_RW + pc * 1024), 16, 0, 0);
            __builtin_amdgcn_global_load_lds((const unsigned*)(UT + rowb * 128 + ((cb ^ (rowb & 7)) << 4)), (LAS unsigned*)(ls + SC_RU + pc * 1024), 16, 0, 0);
        }
    };
    auto dma_g2 = [&](int n) {
        const int cid = (dir * 128 + slot0 + n) * 4 + h;
        const int tbase = dir ? R0 + T - 1 - 64 * n : R0 + 64 * n;
        const char* KdT = p.ws + OFF_R1 + R1_KDT + (size_t)cid * 16384; const char* Ai = p.ws + OFF_R1 + R1_AI + (size_t)cid * 8192;
#pragma unroll
        for (int i = 0; i < 4; ++i) {
            const int pc = wave * 4 + i, rowa = 4 * pc + ra, rowb = 8 * pc + rb;
            const int tok = dir ? tbase - rowa : tbase + rowa;
            __builtin_amdgcn_global_load_lds((const unsigned*)(gq + (size_t)tok * 512 + ((ca ^ (rowa & 15)) << 3)), (LAS unsigned*)(ls + SC_RQ + pc * 1024), 16, 0, 0);
            __builtin_amdgcn_global_load_lds((const unsigned*)(KdT + rowb * 128 + ((cb ^ (rowb & 7)) << 4)), (LAS unsigned*)(ls + SC_RK + pc * 1024), 16, 0, 0);
        }
#pragma unroll
        for (int i = 0; i < 2; ++i) {
            const int pc = wave * 2 + i, rowb = 8 * pc + rb;
            __builtin_amdgcn_global_load_lds((const unsigned*)(Ai + rowb * 128 + ((cb ^ (rowb & 7)) << 4)), (LAS unsigned*)(ls + SC_RA + pc * 1024), 16, 0, 0);
        }
        if (wave == 0) __builtin_amdgcn_global_load_lds((const unsigned*)((const float*)(p.ws + OFF_EGQ) + (size_t)cid * 64 + lane), (LAS unsigned*)(ls + SC_RE), 4, 0, 0);
    };
    __builtin_amdgcn_s_setprio(2);
    dma_g1(0); dma_g2(0);
    f32x16 S[4];
    if (sqi < 2) {
        const float* st = KIN(state_gdn) + ((((size_t)sqi * 2 + l) * 2 + dir) * 4 + h) * 16384;
#pragma unroll
        for (int t = 0; t < 4; ++t)
#pragma unroll
            for (int i = 0; i < 16; ++i) { const float* sb = st + (32 * t + (i & 3) + 8 * (i >> 2)) * 128; S[t][i] = sb[loU]; }
    } else {
#pragma unroll
        for (int t = 0; t < 4; ++t)
#pragma unroll
            for (int i = 0; i < 16; ++i) S[t][i] = 0.f;
    }
    __syncthreads();
    const int m16a = (r & 15) << 4, m16b = (r & 7) << 4;
    const LAS char* bW = ls + SC_RW + r * 256 + 8 * hh; const LAS char* bQ = ls + SC_RQ + r * 256 + 8 * hh;
    const LAS char* bA = ls + SC_RA + r * 128 + 8 * hh; const LAS char* bK = ls + SC_RK + r * 128 + 8 * hh;
    const LAS char* bU = ls + SC_RU + (32 * wave + r) * 128 + 8 * hh;
    for (int n = 0; n < nch; ++n) {
        const int cid = (dir * 128 + slot0 + n) * 4 + h;
        const int tbase = dir ? R0 + T - 1 - 64 * n : R0 + 64 * n;
        const float gt = ((const float*)(p.ws + OFF_GTOT))[cid];
        const bool more = n + 1 < nch;
        bf16x8 Vb[4];
        {
            f32x16 Vp[2];
#pragma unroll
            for (int rt = 0; rt < 2; ++rt)
#pragma unroll
                for (int g = 0; g < 4; ++g) {
                    const u32x2 w = *(const LAS u32x2*)(bU + (m16b ^ ((4 * rt + g) << 4)));
                    Vp[rt][4 * g] = __uint_as_float(w.x << 16); Vp[rt][4 * g + 1] = __uint_as_float(w.x & 0xffff0000u);
                    Vp[rt][4 * g + 2] = __uint_as_float(w.y << 16); Vp[rt][4 * g + 3] = __uint_as_float(w.y & 0xffff0000u);
                }
#pragma unroll
            for (int t = 0; t < 4; ++t)
#pragma unroll
                for (int ss = 0; ss < 2; ++ss) {
                    if (ss == 0) asm volatile("" ::: "memory");
                    const int o = ss * 8, s = 2 * t + ss;
                    const bf16x8 Sb = pack8(S[t][o], S[t][o + 1], S[t][o + 2], S[t][o + 3], S[t][o + 4], S[t][o + 5], S[t][o + 6], S[t][o + 7]);
#pragma unroll
                    for (int rt = 0; rt < 2; ++rt) Vp[rt] = MFMA32(lds_sw(bW + rt * 32 * 256, m16a, 2 * s), Sb, Vp[rt]);
                }
#pragma unroll
            for (int s2 = 0; s2 < 4; ++s2) { const int rt = s2 >> 1, o = (s2 & 1) * 8; Vb[s2] = pack8(Vp[rt][o], Vp[rt][o + 1], Vp[rt][o + 2], Vp[rt][o + 3], Vp[rt][o + 4], Vp[rt][o + 5], Vp[rt][o + 6], Vp[rt][o + 7]); }
        }
        __syncthreads();
        if (more) dma_g1(n + 1);
#pragma unroll
        for (int rt = 0; rt < 2; ++rt) {
            asm volatile("" ::: "memory");
            f32x16 O;
#pragma unroll
            for (int i = 0; i < 16; ++i) O[i] = 0.f;
#pragma unroll
            for (int t = 0; t < 4; ++t)
#pragma unroll
                for (int ss = 0; ss < 2; ++ss) {
                    if (ss == 0 && (t & 1) == 0) asm volatile("" ::: "memory");
                    const int o = ss * 8, s = 2 * t + ss;
                    const bf16x8 Sb = pack8(S[t][o], S[t][o + 1], S[t][o + 2], S[t][o + 3], S[t][o + 4], S[t][o + 5], S[t][o + 6], S[t][o + 7]);
                    O = MFMA32(lds_sw(bQ + rt * 32 * 256, m16a, 2 * s), Sb, O);
                }
#pragma unroll
            for (int i = 0; i < 16; ++i) O[i] *= *(const LAS float*)(ls + SC_RE + (32 * rt + rowmap(i, hh)) * 4);
#pragma unroll
            for (int s2 = 0; s2 < 4; ++s2) O = MFMA32(lds_sw(bA + rt * 32 * 128, m16b, 2 * s2), Vb[s2], O);
#pragma unroll
            for (int i = 0; i < 16; ++i) {
                const int k = 32 * rt + (i & 3) + 8 * (i >> 2);
                float* ob = odir + (size_t)(dir ? tbase - k - 4 : tbase + k) * 512;
                ob[loO] = O[i];
            }
        }
#pragma unroll
        for (int t = 0; t < 4; ++t) {
            asm volatile("" ::: "memory");
#pragma unroll
            for (int i = 0; i < 16; ++i) S[t][i] *= gt;
#pragma unroll
            for (int s2 = 0; s2 < 4; ++s2) S[t] = MFMA32(lds_sw(bK + t * 32 * 128, m16b, 2 * s2), Vb[s2], S[t]);
        }
        __syncthreads();
        if (more) dma_g2(n + 1);
    }
    if (sqi >= 2) {
        float* so = p.out + OUT_STATE + ((((size_t)(sqi - 2) * 2 + l) * 2 + dir) * 4 + h) * 16384;
#pragma unroll
        for (int t = 0; t < 4; ++t)
#pragma unroll
            for (int i = 0; i < 16; ++i) { float* sb = so + (32 * t + (i & 3) + 8 * (i >> 2)) * 128; sb[loU] = S[t][i]; }
    }
    __builtin_amdgcn_s_setprio(0);
}

template <int DQK>
__device__ __forceinline__ void attn_item(const Params& p, int l, int dom, int b, int h, int qt, char* smem) {
    constexpr bool MLA = (DQK == 96);
    constexpr int NS = DQK / 16, KST = (DQK + 8) * 2, VST = 144, NCH = DQK / 8, NLD = NCH * 64 / 256;
    const int tid = ltid(), wave = tid >> 6, lane = tid & 63, r = lane & 31, hh = lane >> 5;
    const int q0 = qt * 128, qpos = q0 + wave * 32 + r;
    const int tokq = (dom ? NCTX + b * 2048 : b * 256) + qpos;
    LAS char* sK = (LAS char*)smem; LAS char* sV = sK + 64 * KST;
    bf16x8 Qf[NS];
    {
        const bf16_t* Qp = MLA ? (const bf16_t*)(p.ws + OFF_QRAW) + (size_t)tokq * 768 + h * 96 : (const bf16_t*)(p.ws + OFF_QSWA) + (size_t)tokq * 512 + h * 64;
#pragma unroll
        for (int s = 0; s < NS; ++s) Qf[s] = *(const bf16x8*)(Qp + 16 * s + 8 * hh);
        if (MLA && dom) {
#pragma unroll
            for (int s = 4; s < NS; ++s) {
                const float pos = (s == 4) ? (float)(qpos >> 6) : (float)(qpos & 63);
                float o[8];
#pragma unroll
                for (int j = 0; j < 8; ++j) {
                    const float xa = bf2f((bf16_t)Qf[s][j]); const float xb = shx(xa, 32, lane);
                    const float ang = pos * exp2f(-(float)j * 1.6609640474f); const float cs = __cosf(ang), sn = __sinf(ang);
                    o[j] = hh ? xa * cs + xb * sn : xa * cs - xb * sn;
                }
                Qf[s] = pack8(o[0], o[1], o[2], o[3], o[4], o[5], o[6], o[7]);
            }
        }
    }
    const bf16_t *Kb, *Vb;
    float m, lsum, sc;
    int nb, t0, nx; bool band = false;
    if (MLA) {
        const size_t pr = dom ? 32768 + (size_t)(b * 8 + h) * 2560 : (size_t)(b * 8 + h) * 256;
        Kb = (const bf16_t*)(p.ws + OFF_KMLA) + pr * 96; Vb = (const bf16_t*)(p.ws + OFF_VMLA) + pr * 64;
        m = -INFINITY; lsum = 0.f; sc = 0.10206207261596577f * LOG2E; t0 = 0; nx = 0; nb = dom ? 40 : 4;
    } else {
        const int kvh = h >> 2; const size_t pr = dom ? 8192 + (size_t)(b * 2 + kvh) * 2560 : (size_t)(b * 2 + kvh) * 256;
        Kb = (const bf16_t*)(p.ws + OFF_KSWA) + pr * 64; Vb = (const bf16_t*)(p.ws + OFF_VSWA) + pr * 64;
        m = KIN(swa_sink)[l * 8 + h] * LOG2E; lsum = 1.f; sc = 0.125f * LOG2E;
        if (dom) { const int lo = (q0 - 128 > 0 ? q0 - 128 : 0) >> 6, hi = (q0 + 256 < 2048 ? q0 + 256 : 2048) >> 6; t0 = lo; nb = hi - lo; nx = 8; band = true; }
        else { t0 = 0; nb = 4; nx = 0; }
    }
    const int ntile = nb + nx;
    f32x16 oacc[2];
#pragma unroll
    for (int i = 0; i < 16; ++i) { oacc[0][i] = 0.f; oacc[1][i] = 0.f; }
    u32x4 rkA[NLD], rvA[2], rkB[NLD], rvB[2];
    auto key0_of = [&](int ti) { return ti < nb ? 64 * (t0 + ti) : 2048 + 64 * (ti - nb); };
    auto prefetch = [&](int ti, u32x4 (&rkc)[NLD], u32x4 (&rvc)[2]) {
        const int k0 = key0_of(ti);
#pragma unroll
        for (int i = 0; i < NLD; ++i) { const int c = tid + 256 * i, row = c / NCH, ch = c % NCH; rkc[i] = *(const u32x4*)(Kb + (size_t)(k0 + row) * DQK + ch * 8); }
#pragma unroll
        for (int i = 0; i < 2; ++i) { const int c = tid + 256 * i, key = c & 63, ch = c >> 6; rvc[i] = *(const u32x4*)(Vb + (size_t)(k0 + key) * 64 + ch * 8); }
    };
    auto step = [&](int ti, u32x4 (&rkc)[NLD], u32x4 (&rvc)[2]) {
        __syncthreads();
#pragma unroll
        for (int i = 0; i < NLD; ++i) { const int c = tid + 256 * i, row = c / NCH, ch = c % NCH; *(LAS u32x4*)(sK + row * KST + ch * 16) = rkc[i]; }
#pragma unroll
        for (int i = 0; i < 2; ++i) {
            const int c = tid + 256 * i, key = c & 63, ch = c >> 6; const unsigned w4[4] = {rvc[i].x, rvc[i].y, rvc[i].z, rvc[i].w};
#pragma unroll
            for (int e = 0; e < 4; ++e) {
                *(LAS bf16_t*)(sV + (ch * 8 + 2 * e) * VST + key * 2) = (bf16_t)(w4[e] & 0xffffu);
                *(LAS bf16_t*)(sV + (ch * 8 + 2 * e + 1) * VST + key * 2) = (bf16_t)(w4[e] >> 16);
            }
        }
        __syncthreads();
        const int k0 = key0_of(ti); const bool msk = band && ti < nb;
        if (ti + 2 < ntile) prefetch(ti + 2, rkc, rvc);
        f32x16 sacc[2];
        __builtin_amdgcn_s_setprio(1);
#pragma unroll
        for (int rt = 0; rt < 2; ++rt) {
#pragma unroll
            for (int i = 0; i < 16; ++i) sacc[rt][i] = 0.f;
#pragma unroll
            for (int s = 0; s < NS; ++s) { const bf16x8 kf = *(const LAS bf16x8*)(sK + (32 * rt + r) * KST + (16 * s + 8 * hh) * 2); sacc[rt] = MFMA32(kf, Qf[s], sacc[rt]); }
        }
        __builtin_amdgcn_s_setprio(0);
        float mx = -INFINITY;
#pragma unroll
        for (int rt = 0; rt < 2; ++rt)
#pragma unroll
            for (int i = 0; i < 16; ++i) {
                float v = sacc[rt][i] * sc;
                if (msk) { const int key = k0 + 32 * rt + rowmap(i, hh); const int d = qpos - key; if (d > 128 || d < -128) v = -INFINITY; }
                sacc[rt][i] = v; mx = fmaxf(mx, v);
            }
        mx = fmaxf(mx, shx(mx, 32, lane));
        const float mnew = fmaxf(m, mx), muse = (mnew == -INFINITY) ? 0.f : mnew;
        const float alpha = __builtin_amdgcn_exp2f(m - muse);
        float rs = 0.f;
#pragma unroll
        for (int rt = 0; rt < 2; ++rt)
#pragma unroll
            for (int i = 0; i < 16; ++i) { const float pv = __builtin_amdgcn_exp2f(sacc[rt][i] - muse); sacc[rt][i] = pv; rs += pv; }
        rs += shx(rs, 32, lane);
        lsum = lsum * alpha + rs; m = mnew;
#pragma unroll
        for (int i = 0; i < 16; ++i) { oacc[0][i] *= alpha; oacc[1][i] *= alpha; }
        __builtin_amdgcn_s_setprio(1);
#pragma unroll
        for (int s2 = 0; s2 < 4; ++s2) {
            const int rt = s2 >> 1, o = (s2 & 1) * 8;
            const bf16x8 pf = pack8(sacc[rt][o], sacc[rt][o + 1], sacc[rt][o + 2], sacc[rt][o + 3], sacc[rt][o + 4], sacc[rt][o + 5], sacc[rt][o + 6], sacc[rt][o + 7]);
#pragma unroll
            for (int dt = 0; dt < 2; ++dt) {
                oacc[dt] = MFMA32(lds2x8(sV + (32 * dt + r) * VST + (16 * s2 + 4 * hh) * 2), pf, oacc[dt]);
            }
        }
        __builtin_amdgcn_s_setprio(0);
    };
    prefetch(0, rkA, rvA);
    if (ntile > 1) prefetch(1, rkB, rvB);
    for (int ti = 0; ti < ntile; ti += 2) {
        step(ti, rkA, rvA);
        if (ti + 1 < ntile) step(ti + 1, rkB, rvB);
    }
    const float inv = 1.f / lsum;
    bf16_t* mix = (bf16_t*)(p.ws + OFF_H) + (size_t)tokq * 1536 + (MLA ? 0 : 512) + h * 64;
#pragma unroll
    for (int dt = 0; dt < 2; ++dt)
#pragma unroll
        for (int g = 0; g < 4; ++g) {
            u32x2 pk; pk.x = cvtpk(oacc[dt][4 * g] * inv, oacc[dt][4 * g + 1] * inv); pk.y = cvtpk(oacc[dt][4 * g + 2] * inv, oacc[dt][4 * g + 3] * inv);
            *(u32x2*)(mix + 32 * dt + 8 * g + 4 * hh) = pk;
        }
}

__device__ __forceinline__ void gdn_post(const Params& p, int l, int tok0, int lane) {
    const float* gn = KIN(gdn_norm) + l * 128;
    const float g0 = gn[lane], g1 = gn[lane + 64];
    float v0[4][4], v1[4][4], z0[4][4], z1[4][4];
#pragma unroll
    for (int j = 0; j < 4; ++j) {
        const float* of = (const float*)(p.ws + OFF_GK) + (size_t)(tok0 + j) * 512; const float* ob = of + (size_t)8192 * 512;
        const bf16_t* gz = (const bf16_t*)(p.ws + OFF_GZ) + (size_t)(tok0 + j) * 512;
#pragma unroll
        for (int hd = 0; hd < 4; ++hd) {
            const int c0 = hd * 128 + lane, c1 = c0 + 64;
            v0[j][hd] = of[c0] + ob[c0]; v1[j][hd] = of[c1] + ob[c1]; z0[j][hd] = bf2f(gz[c0]); z1[j][hd] = bf2f(gz[c1]);
        }
    }
#pragma unroll
    for (int j = 0; j < 4; ++j) {
        bf16_t* mix = (bf16_t*)(p.ws + OFF_H) + (size_t)(tok0 + j) * 1536 + 1024;
        float ss[4];
#pragma unroll
        for (int hd = 0; hd < 4; ++hd) ss[hd] = v0[j][hd] * v0[j][hd] + v1[j][hd] * v1[j][hd];
#pragma unroll
        for (int m = 32; m >= 1; m >>= 1)
#pragma unroll
            for (int hd = 0; hd < 4; ++hd) ss[hd] += shx(ss[hd], m, lane);
#pragma unroll
        for (int hd = 0; hd < 4; ++hd) {
            const float rs = rsqrtf(ss[hd] * (1.f / 128.f) + NEPS);
            mix[hd * 128 + lane] = f2bf(v0[j][hd] * rs * g0 * siluf(z0[j][hd]));
            mix[hd * 128 + lane + 64] = f2bf(v1[j][hd] * rs * g1 * siluf(z1[j][hd]));
        }
    }
}

__host__ __device__ constexpr int kind_items(int q) {
    switch (q) {
        case 0: case 3: case 10: return 512;
        case 1: case 11: return 64 * 44;
        case 2: case 12: return 64 * 8;
        case 4: return 64 * 28;
        case 5: return 512 + 2048 + 256;
        case 6: return 1024 + 384 + 576;
        case 7: return 144 + 1024;
        case 8: return 512;
        case 9: return 64 * 8;
        case 13: return 288 + CONV_PER_LAYER + 1024;
        default: return 512;
    }
}
template <int Q>
__device__ __forceinline__ void run_item(const Params& p, int l, int item, char* smem) {
    const int tid = ltid(), wave = tid >> 6, lane = tid & 63;
    char* wb = p.ws + OFF_W + (size_t)l * LAYER_W;
    const float* mod = (const float*)(p.ws + OFF_MOD) + (size_t)l * 3 * 9216;
    EpiArgs e; e.out = nullptr; e.ld = 0; e.gate = nullptr; e.scale = 1.f;
    if constexpr (Q == 13) {
        if (item < 288) p0_ada(p, item, smem);
        else if (item < 288 + CONV_PER_LAYER) p0_conv(p, item - 288, smem);
        else p0_copy(p, item - 288 - CONV_PER_LAYER);
    } else if constexpr (Q == 14) { normmod_item(p, 0, 3, item);
    } else if constexpr (Q == 0) { normmod_item(p, l, 0, item);
    } else if constexpr (Q == 3) { normmod_item(p, l, 1, item);
    } else if constexpr (Q == 10) { normmod_item(p, l, 2, item);
    } else if constexpr (Q == 1 || Q == 11) {
        e.out = p.ws + OFF_R1;
        gemm_tile<EPI_SWIGLU>((const bf16_t*)(p.ws + OFF_H), 1024, (const bf16_t*)(wb + (Q == 1 ? WO_W1A : WO_W1B)), 1024, item & 63, item >> 6, e, smem);
    } else if constexpr (Q == 2 || Q == 12) {
        e.out = p.out + OUT_Y; e.gate = mod + (Q == 2 ? 2 : 8) * 1024; e.scale = 0.5f;
        gemm_tile<EPI_RESID>((const bf16_t*)(p.ws + OFF_R1), DFF, (const bf16_t*)(wb + (Q == 2 ? WO_W2A : WO_W2B)), DFF, item & 63, item >> 6, e, smem);
    } else if constexpr (Q == 4) {
        e.out = p.ws + OFF_R1; e.ld = UW;
        gemm_tile<EPI_BF16>((const bf16_t*)(p.ws + OFF_H), 1024, (const bf16_t*)(wb + WO_WIN), 1024, item & 63, item >> 6, e, smem);
    } else if constexpr (Q == 5) {
        if (item < 512) f1_conv(p, l, item, wave, lane); else if (item < 2560) f1_token(p, l, (item - 512) * 4 + wave, lane); else f1_cache(p, l, (item - 2560) * 4 + wave, lane);
    } else if constexpr (Q == 6) {
        if (item < 1024) gdn_prep(p, item, smem);
        else if (item < 1024 + 384) { const int t = item - 1024; e.out = p.ws + OFF_QRAW; e.ld = 768;
            gemm_tile<EPI_BF16>((const bf16_t*)(p.ws + OFF_CQN), 384, (const bf16_t*)(wb + WO_WQB), 384, t & 63, t >> 6, e, smem); }
        else { const int t = item - 1408; e.out = (void*)&p;
            gemm_tile<EPI_KV>((const bf16_t*)(p.ws + OFF_CKVA), 256, (const bf16_t*)(wb + WO_WKVB), 256, t % 72, t / 72, e, smem); }
    } else if constexpr (Q == 7) {
        if (item < 144) gdn_scan(p, l, item, smem);
        else if (item >= 1168) p0_conv(p, CONV_PER_LAYER + (item - 1168), smem);
        else {
            const int a = item - 144, grp = a >> 8, i = a & 255;
            if (grp == 0) attn_item<96>(p, l, 1, i >> 7, (i >> 4) & 7, i & 15, smem);
            else if (grp == 1) attn_item<64>(p, l, 1, i >> 7, (i >> 4) & 7, i & 15, smem);
            else if (grp == 2) attn_item<96>(p, l, 0, i >> 4, (i >> 1) & 7, i & 1, smem);
            else attn_item<64>(p, l, 0, i >> 4, (i >> 1) & 7, i & 1, smem);
        }
    } else if constexpr (Q == 8) { gdn_post(p, l, item * 16 + wave * 4, lane);
    } else {
        e.out = p.out + OUT_Y; e.gate = mod + 5 * 1024; e.scale = 1.f;
        gemm_tile<EPI_RESID>((const bf16_t*)(p.ws + OFF_H), 1536, (const bf16_t*)(wb + WO_WOUT), 1536, item & 63, item >> 6, e, smem);
    }
}

template <int Q>
__global__ void __launch_bounds__(256, 2) k_phase(Params p, int l) {
    __shared__ __attribute__((aligned(16))) char smem[SMEM_BYTES];
    run_item<Q>(p, l, blockIdx.x, smem);
}

#if MEGA

#define XB_TMO      128
#define XB_XCNT(j)  (256  + 64 * (j))
#define XB_XSUB(j)  (1280 + 64 * (j))
#define XB_XGEN(j)  (2304 + 64 * (j))
#define XB_TOP      3328
#define XB_TOPGEN   3392
#define XCD_BAR_WORDS 3456
#define CTR_WORD0   3584
#define XB_SPIN_CAP (1u << 18)
__device__ __forceinline__ unsigned xb_ld(unsigned* p)              { return __hip_atomic_load(p, __ATOMIC_RELAXED, __HIP_MEMORY_SCOPE_AGENT); }
__device__ __forceinline__ unsigned xb_add(unsigned* p, unsigned v) { return __hip_atomic_fetch_add(p, v, __ATOMIC_RELAXED, __HIP_MEMORY_SCOPE_AGENT); }
__device__ __forceinline__ unsigned xb_xcc_id() { return (unsigned)__builtin_amdgcn_s_getreg((3 << 11) | 20) & 0xFu; }
#define XB_SPIN(cond, bar) do { unsigned _sp = 0; while (cond) { __builtin_amdgcn_s_sleep(1); \
    if ((++_sp & 255u) == 0u) { if (xb_ld(&(bar)[XB_TMO])) break; if (_sp > XB_SPIN_CAP) { atomicAdd(&(bar)[XB_TMO], 1u); break; } } } } while (0)
struct XcdBarrier { unsigned* bar; unsigned x; volatile LAS unsigned* st; };
__device__ __forceinline__ XcdBarrier xcd_barrier_post(unsigned* bar, volatile LAS unsigned* st) {
    XcdBarrier b; b.bar = bar; b.x = xb_xcc_id(); b.st = st;
    if (ltid() == 0) (void)xb_add(&bar[XB_XCNT(b.x)], 1u);
    return b;
}
__device__ __forceinline__ void xcd_barrier_complete(unsigned* bar, unsigned x, unsigned& nloc, unsigned& nx) {
    const unsigned G = gridDim.x * gridDim.y * gridDim.z;
    unsigned sum, cnt, mine, sp = 0u;
    for (;;) {
        sum = 0u; cnt = 0u; mine = 0u;
#pragma unroll
        for (unsigned j = 0; j < 16; ++j) { const unsigned c = xb_ld(&bar[XB_XCNT(j)]); sum += c; cnt += (c > 0u) ? 1u : 0u; mine = (j == x) ? c : mine; }
        if (sum == G) break;
        __builtin_amdgcn_s_sleep(1);
        if ((++sp & 255u) == 0u) { if (xb_ld(&bar[XB_TMO])) break; if (sp > XB_SPIN_CAP) { atomicAdd(&bar[XB_TMO], 1u); break; } }
    }
    nloc = mine > 0u ? mine : 1u; nx = cnt > 0u ? cnt : 1u;
}
__device__ __forceinline__ void xcd_barrier(const Params& p, char* smem) {
    XcdBarrier b; b.bar = (unsigned*)(p.ws + OFF_CTRL); b.x = xb_xcc_id(); b.st = (volatile LAS unsigned*)((LAS char*)smem + SMEM_BYTES - 16);
    asm volatile("s_waitcnt vmcnt(0)" ::: "memory");
    __syncthreads();
    if (ltid() == 0) {
        unsigned* bar = b.bar;
        __builtin_amdgcn_s_waitcnt(0);
        unsigned nloc = b.st[0], nx = b.st[1];
        if (nloc == 0u) { xcd_barrier_complete(bar, b.x, nloc, nx); b.st[0] = nloc; b.st[1] = nx; }
        const unsigned old = xb_add(&bar[XB_XSUB(b.x)], 1u);
        const unsigned gen = old / nloc;
        if (old + 1u == (gen + 1u) * nloc) {
            __builtin_amdgcn_fence(__ATOMIC_RELEASE, "agent");
            asm volatile("s_waitcnt vmcnt(0)" ::: "memory");
            const unsigned og = xb_add(&bar[XB_TOP], 1u);
            const unsigned tg = og / nx;
            if (og + 1u == (tg + 1u) * nx) xb_add(&bar[XB_TOPGEN], 1u);
            else XB_SPIN(xb_ld(&bar[XB_TOPGEN]) == tg, bar);
            __builtin_amdgcn_fence(__ATOMIC_ACQUIRE, "agent");
            xb_add(&bar[XB_XGEN(b.x)], 1u);
            asm volatile("s_waitcnt vmcnt(0)" ::: "memory");
        } else {
            XB_SPIN(xb_ld(&bar[XB_XGEN(b.x)]) == gen, bar);
            __builtin_amdgcn_fence(__ATOMIC_ACQUIRE, "agent");
            asm volatile("s_waitcnt vmcnt(0)" ::: "memory");
        }
    }
    __syncthreads();
}
template <int Q>
__device__ __forceinline__ void mega_phase(const Params& p, int l, char* smem, int xb, int rep = 0) {
    int n = kind_items(Q);
    if (Q == 7 && l == 0) n += CONV_PER_LAYER;
#ifdef DUP6_PREP_ONLY
    if (Q == 6 && rep == 1) n = 1024;
#endif

    if constexpr (Q == 6 || Q == 7) {
        int* ctr = (int*)(p.ws + OFF_CTRL) + CTR_WORD0 + l * 16 + Q + rep * 64;
        LAS int* sitem = (LAS int*)((LAS char*)smem + SMEM_BYTES - 32);
        for (;;) {
            __syncthreads();
            if (ltid() == 0) *sitem = atomicAdd(ctr, 1);
            __syncthreads();
            const int item = __builtin_amdgcn_readfirstlane(*sitem);
            if (item >= n) break;
            __syncthreads();
            Params q = p; { size_t z = 0; asm volatile("" : "+s"(z)); q.ws = p.ws + z; q.out = p.out + z; }
            run_item<Q>(q, l, item, smem);
        }
    } else {
        int b0 = blockIdx.x; asm volatile("" : "+s"(b0));
        for (int item = b0; item < n; item += gridDim.x) {
            __syncthreads();
            Params q = p; { size_t z = 0; asm volatile("" : "+s"(z)); q.ws = p.ws + z; q.out = p.out + z; }
            run_item<Q>(q, l, item, smem);
        }
    }
    xcd_barrier(p, smem);
}

__global__ void __launch_bounds__(256, 2) k_mega(Params p) {
    __shared__ __attribute__((aligned(16))) char smem[SMEM_BYTES];
    if (p.ws == nullptr) cg::this_grid().sync();
    volatile LAS unsigned* stw = (volatile LAS unsigned*)(smem + SMEM_BYTES - 16);
    if (ltid() == 0) { stw[0] = 0u; stw[1] = 0u; }
    __syncthreads();
    (void)xcd_barrier_post((unsigned*)(p.ws + OFF_CTRL), stw);
    const int grid = 0;
    mega_phase<13>(p, 0, smem, grid);
#ifdef DUP13
    mega_phase<13>(p, 0, smem, grid, 1);
#endif

    for (int l = 0; l < 2; ++l) {
        mega_phase<0>(p, l, smem, grid);
#if defined(DUPQ) && DUPQ == 0
        mega_phase<0>(p, l, smem, grid, 1);
#endif
 mega_phase<1>(p, l, smem, grid);
#ifdef DUP1
        mega_phase<1>(p, l, smem, grid, 1);
#endif
 mega_phase<2>(p, l, smem, grid); mega_phase<3>(p, l, smem, grid);
#if defined(DUPQ) && DUPQ == 3
        mega_phase<3>(p, l, smem, grid, 1);
#endif

        mega_phase<4>(p, l, smem, grid);
#if defined(DUPQ) && DUPQ == 4
        mega_phase<4>(p, l, smem, grid, 1);
#endif
 mega_phase<5>(p, l, smem, grid);
#ifdef DUP5
        mega_phase<5>(p, l, smem, grid, 1);
#endif
 mega_phase<6>(p, l, smem, grid);
#ifdef DUP6
        mega_phase<6>(p, l, smem, grid, 1);
#endif
 mega_phase<7>(p, l, smem, grid);
#ifdef DUP7
        mega_phase<7>(p, l, smem, grid, 1);
#endif

        mega_phase<8>(p, l, smem, grid);
#if defined(DUPQ) && DUPQ == 8
        mega_phase<8>(p, l, smem, grid, 1);
#endif
 mega_phase<9>(p, l, smem, grid); mega_phase<10>(p, l, smem, grid);
#if defined(DUPQ) && DUPQ == 10
        mega_phase<10>(p, l, smem, grid, 1);
#endif
 mega_phase<11>(p, l, smem, grid);
#if defined(DUPQ) && DUPQ == 11
        mega_phase<11>(p, l, smem, grid, 1);
#endif

        mega_phase<12>(p, l, smem, grid);
    }
    mega_phase<14>(p, 0, smem, grid);
}

#else
template <int Q> static void launch_kind(const Params& p, int l, hipStream_t stream) {
    hipLaunchKernelGGL(k_phase<Q>, dim3(kind_items(Q)), dim3(256), 0, stream, p, l);
}

#endif
extern "C" void kernel_launch(void* const* d_in, const int* in_sizes, int n_in, void* d_out, int out_size, void* d_ws, size_t ws_size, hipStream_t stream) {
    Params p{};
    const float** pp = (const float**)&p;
    for (int i = 0; i < 30; ++i) pp[i] = (const float*)d_in[i];
    p.out = (float*)d_out; p.ws = (char*)d_ws;
    if (ws_size < WS_TOTAL) { fprintf(stderr, "workspace too small: %zu < %zu\n", ws_size, (size_t)WS_TOTAL); return; }
#if MEGA
    hipMemsetAsync(d_ws, 0, 16384, stream);
    static int grid_blocks = 0;
    if (!grid_blocks) {
        int dev = 0, cus = 0, per_cu = 0;
        hipGetDevice(&dev); hipDeviceGetAttribute(&cus, hipDeviceAttributeMultiprocessorCount, dev);
        hipOccupancyMaxActiveBlocksPerMultiprocessor(&per_cu, k_mega, 256, 0);
        if (per_cu > 2) per_cu = 2;
        grid_blocks = cus * per_cu;
    }
    void* args[] = {&p};
    hipError_t err = hipLaunchCooperativeKernel((void*)k_mega, dim3(grid_blocks), dim3(256), args, 0, stream);
    if (err != hipSuccess) fprintf(stderr, "cooperative launch failed: %s (grid %d)\n", hipGetErrorString(err), grid_blocks);
#else
#ifndef DBG_STOP
#define DBG_STOP 99
#endif
    if (DBG_STOP < 99) hipMemsetAsync(d_out, 0, (size_t)out_size * 4, stream);
    launch_kind<13>(p, 0, stream);
    for (int l = 0; l < 2; ++l) {
        const int lim = DBG_STOP - 13 * l;
        if (lim > 0) launch_kind<0>(p, l, stream);
        if (lim > 1) launch_kind<1>(p, l, stream);
        if (lim > 2) launch_kind<2>(p, l, stream);
        if (lim > 3) launch_kind<3>(p, l, stream);
        if (lim > 4) launch_kind<4>(p, l, stream);
        if (lim > 5) launch_kind<5>(p, l, stream);
        if (lim > 6) launch_kind<6>(p, l, stream);
        if (lim > 7) launch_kind<7>(p, l, stream);
        if (lim > 8) launch_kind<8>(p, l, stream);
        if (lim > 9) launch_kind<9>(p, l, stream);
        if (lim > 10) launch_kind<10>(p, l, stream);
        if (lim > 11) launch_kind<11>(p, l, stream);
        if (lim > 12) launch_kind<12>(p, l, stream);
    }
    launch_kind<14>(p, 0, stream);
#endif
}
```

```cpp
#include <hip/hip_runtime.h>
#include <hip/hip_cooperative_groups.h>
#include <stdint.h>
#include <stdio.h>
namespace cg = cooperative_groups;

#ifndef MEGA
#define MEGA 1
#endif


typedef unsigned short bf16_t;
typedef short bf16x8 __attribute__((ext_vector_type(8)));
typedef float f32x4 __attribute__((ext_vector_type(4)));
typedef float f32x16 __attribute__((ext_vector_type(16)));
typedef unsigned u32x4 __attribute__((ext_vector_type(4)));
typedef unsigned u32x2 __attribute__((ext_vector_type(2)));

#define NTOK 8192
#define NCTX 4096
#define DM 1024
#define DFF 2816
#define UW 3584
#define LOG2E 1.4426950408889634f
#define LAS __attribute__((address_space(3)))
#define NEPS 1e-6f
#define SMEM_BYTES 74240

#define U_CQ 0
#define U_CKV 384
#define U_KR 640
#define U_SQ 672
#define U_SK 1184
#define U_SV 1312
#define U_GQKV 1440
#define U_GZ 2976
#define U_GATE 3488

constexpr size_t SZ_W1T = (size_t)5632 * 1024 * 2, SZ_W2T = (size_t)1024 * 2816 * 2, SZ_WINT = (size_t)3584 * 1024 * 2,
                 SZ_WQBT = (size_t)768 * 384 * 2, SZ_WKVBT = (size_t)1024 * 256 * 2, SZ_WOUTT = (size_t)1024 * 1536 * 2;
constexpr size_t WO_W1A = 0, WO_W2A = WO_W1A + SZ_W1T, WO_WIN = WO_W2A + SZ_W2T, WO_WQB = WO_WIN + SZ_WINT, WO_WKVB = WO_WQB + SZ_WQBT,
                 WO_WOUT = WO_WKVB + SZ_WKVBT, WO_W1B = WO_WOUT + SZ_WOUTT, WO_W2B = WO_W1B + SZ_W1T, LAYER_W = WO_W2B + SZ_W2T;
constexpr size_t OFF_CTRL = 0, OFF_MOD = 16384, OFF_W = OFF_MOD + (size_t)2 * 3 * 9216 * 4, OFF_H = OFF_W + 2 * LAYER_W,
                 OFF_CQN = OFF_H + (size_t)8192 * 1024 * 2, OFF_CKVA = OFF_CQN + (size_t)8192 * 384 * 2,
                 OFF_R1 = OFF_CKVA + (size_t)9216 * 256 * 2, SZ_R1 = (size_t)8192 * 3584 * 2,
                 OFF_QRAW = OFF_R1 + SZ_R1, OFF_KMLA = OFF_QRAW + (size_t)8192 * 768 * 2, OFF_VMLA = OFF_KMLA + (size_t)73728 * 96 * 2,
                 OFF_QSWA = OFF_VMLA + (size_t)73728 * 64 * 2, OFF_KSWA = OFF_QSWA + (size_t)8192 * 512 * 2,
                 OFF_VSWA = OFF_KSWA + (size_t)18432 * 64 * 2, OFF_GQ = OFF_VSWA + (size_t)18432 * 64 * 2,
                 OFF_GZ = OFF_GQ + (size_t)8192 * 512 * 2, OFF_GK = OFF_GZ + (size_t)8192 * 512 * 2, OFF_GV = OFF_GK + (size_t)8192 * 512 * 4,
                 OFF_GG = OFF_GV + (size_t)8192 * 512 * 4, OFF_GB = OFF_GG + (size_t)8192 * 8 * 4, OFF_GTOT = OFF_GB + (size_t)8192 * 8 * 4,
                 OFF_EGQ = OFF_GTOT + 4096, WS_TOTAL = OFF_EGQ + (size_t)1024 * 64 * 4;
constexpr size_t R1_U = 0, R1_KDT = (size_t)1024 * 16384, R1_WN = 2 * R1_KDT, R1_AI = 3 * R1_KDT;

#define OUT_Y 0
#define OUT_CKV 8388608
#define OUT_KROPE 10485760
#define OUT_SWAK 10747904
#define OUT_SWAV 11796480
#define OUT_STATE 12845056

struct Params {
    const float *x_prompt, *x_sample, *c_mla_ckv, *c_mla_krope, *c_swa_k, *c_swa_v, *state_gdn, *c, *c_ctx, *w_ada, *b_ada, *norm_ffn1,
        *ffn1_w1, *ffn1_w2, *norm_mix, *w_in, *mla_q_norm, *mla_w_qb, *mla_kv_norm, *mla_w_kvb, *swa_sink, *gdn_conv_w, *gdn_a_log,
        *gdn_dt_bias, *gdn_norm, *w_out, *norm_ffn2, *ffn2_w1, *ffn2_w2, *final_norm;
    float* out;
    char* ws;
};


#define GAS __attribute__((address_space(1)))
#define CAS __attribute__((address_space(4)))
__device__ __forceinline__ const float* kin(int byte_off) {
    const CAS char* ka = (const CAS char*)__builtin_amdgcn_kernarg_segment_ptr();
    unsigned z = 0; asm volatile("" : "+s"(z));
    const unsigned long long v = *(const CAS unsigned long long*)(ka + byte_off + z);
    return (const float*)(GAS const float*)v;
}
#define KIN(f) kin((int)__builtin_offsetof(Params, f))
__device__ __forceinline__ int ltid() { int t = threadIdx.x; asm volatile("" : "+v"(t)); return t; }
__device__ __forceinline__ float bf2f(bf16_t v) { return __uint_as_float(((unsigned)v) << 16); }
typedef float f32x2_t __attribute__((ext_vector_type(2)));
typedef __bf16 bf16x2_t __attribute__((ext_vector_type(2)));
__device__ __forceinline__ unsigned cvtpk(float lo, float hi) { f32x2_t v = {lo, hi}; bf16x2_t b = __builtin_convertvector(v, bf16x2_t); return __builtin_bit_cast(unsigned, b); }
__device__ __forceinline__ bf16_t f2bf(float f) { return (bf16_t)(cvtpk(f, 0.f) & 0xffffu); }
__device__ __forceinline__ bf16x8 pack8(float a0, float a1, float a2, float a3, float a4, float a5, float a6, float a7) {
    u32x4 w; w.x = cvtpk(a0, a1); w.y = cvtpk(a2, a3); w.z = cvtpk(a4, a5); w.w = cvtpk(a6, a7); return __builtin_bit_cast(bf16x8, w);
}
__device__ __forceinline__ bf16x8 ld2x8(const bf16_t* p0, const bf16_t* p1) {
    u32x2 a = *(const u32x2*)p0, b = *(const u32x2*)p1; u32x4 w; w.x = a.x; w.y = a.y; w.z = b.x; w.w = b.y; return __builtin_bit_cast(bf16x8, w);
}
__device__ __forceinline__ float shx(float v, int m, int lane) { return __int_as_float(__builtin_amdgcn_ds_bpermute((lane ^ m) << 2, __float_as_int(v))); }
__device__ __forceinline__ float wave_sum(float v, int lane) {
    v += shx(v, 32, lane); v += shx(v, 16, lane); v += shx(v, 8, lane); v += shx(v, 4, lane); v += shx(v, 2, lane); v += shx(v, 1, lane); return v;
}
__device__ __forceinline__ float siluf(float x) { return x * __builtin_amdgcn_rcpf(1.f + __expf(-x)); }
__device__ __forceinline__ int modrow(int tok) { return tok < NCTX ? 0 : 1 + ((tok - NCTX) >> 11); }
__device__ __forceinline__ int rowmap(int i, int hh) { return (i & 3) + 8 * (i >> 2) + 4 * hh; }
#define MFMA32(a, b, c) __builtin_amdgcn_mfma_f32_32x32x16_bf16(a, b, c, 0, 0, 0)
#define MFMA16(a, b, c) __builtin_amdgcn_mfma_f32_16x16x32_bf16(a, b, c, 0, 0, 0)

__device__ __forceinline__ void p0_ada(const Params& p, int it, char* smem) {
    const int tid = ltid(), l = it / 144, n0 = (it % 144) * 64, w = tid >> 6, lane = tid & 63;
    LAS float* s = (LAS float*)(LAS char*)smem;
    LAS float* red = s + 3072;
    for (int k = tid; k < 1024; k += 256) {
        s[k] = siluf(KIN(c_ctx)[k]); s[1024 + k] = siluf(KIN(c)[k]); s[2048 + k] = siluf(KIN(c)[1024 + k]);
    }
    __syncthreads();
    const float* wp = KIN(w_ada) + ((size_t)l * 1024 + w * 256) * 9216 + n0 + lane;
    float a0 = 0.f, a1 = 0.f, a2 = 0.f;
#pragma unroll 32
    for (int k = 0; k < 256; ++k) {
        const float wv = wp[(size_t)k * 9216]; const int kk = w * 256 + k;
        a0 += s[kk] * wv; a1 += s[1024 + kk] * wv; a2 += s[2048 + kk] * wv;
    }
    red[(w * 3 + 0) * 64 + lane] = a0; red[(w * 3 + 1) * 64 + lane] = a1; red[(w * 3 + 2) * 64 + lane] = a2;
    __syncthreads();
    if (tid < 192) {
        const int r = tid >> 6;
        const float v = red[(0 * 3 + r) * 64 + lane] + red[(1 * 3 + r) * 64 + lane] + red[(2 * 3 + r) * 64 + lane] + red[(3 * 3 + r) * 64 + lane];
        float* mod = (float*)(p.ws + OFF_MOD);
        mod[((size_t)l * 3 + r) * 9216 + n0 + lane] = v + KIN(b_ada)[(size_t)l * 9216 + n0 + lane];
    }
}

__device__ __forceinline__ void conv_desc(const Params& p, int l, int w, const float*& src, bf16_t*& dst, int& K, int& Nsrc, int& Ndst, int& Nvalid, int& mode) {
    char* wb = p.ws + OFF_W + (size_t)l * LAYER_W; mode = 0;
    switch (w) {
        case 0: src = KIN(ffn1_w1) + (size_t)l * 1024 * 5632; dst = (bf16_t*)(wb + WO_W1A); K = 1024; Nsrc = 5632; Ndst = 5632; Nvalid = 5632; mode = 1; break;
        case 1: src = KIN(ffn1_w2) + (size_t)l * 2816 * 1024; dst = (bf16_t*)(wb + WO_W2A); K = 2816; Nsrc = 1024; Ndst = 1024; Nvalid = 1024; break;
        case 2: src = KIN(w_in) + (size_t)l * 1024 * 3504; dst = (bf16_t*)(wb + WO_WIN); K = 1024; Nsrc = 3504; Ndst = 3584; Nvalid = 3504; break;
        case 3: src = KIN(mla_w_qb) + (size_t)l * 384 * 768; dst = (bf16_t*)(wb + WO_WQB); K = 384; Nsrc = 768; Ndst = 768; Nvalid = 768; break;
        case 4: src = KIN(mla_w_kvb) + (size_t)l * 256 * 1024; dst = (bf16_t*)(wb + WO_WKVB); K = 256; Nsrc = 1024; Ndst = 1024; Nvalid = 1024; break;
        case 5: src = KIN(w_out) + (size_t)l * 1536 * 1024; dst = (bf16_t*)(wb + WO_WOUT); K = 1536; Nsrc = 1024; Ndst = 1024; Nvalid = 1024; break;
        case 6: src = KIN(ffn2_w1) + (size_t)l * 1024 * 5632; dst = (bf16_t*)(wb + WO_W1B); K = 1024; Nsrc = 5632; Ndst = 5632; Nvalid = 5632; mode = 1; break;
        default: src = KIN(ffn2_w2) + (size_t)l * 2816 * 1024; dst = (bf16_t*)(wb + WO_W2B); K = 2816; Nsrc = 1024; Ndst = 1024; Nvalid = 1024; break;
    }
}
#define CONV_PER_LAYER 1416
__device__ __forceinline__ void p0_conv(const Params& p, int it, char* smem) {
    const int tid = ltid();
    const int l = it / CONV_PER_LAYER; int r = it % CONV_PER_LAYER;
    const int cnt[8] = {352, 176, 224, 24, 16, 96, 352, 176};
    int w = 0;
#pragma unroll
    for (int i = 0; i < 7; ++i) { if (w == i && r >= cnt[i]) { r -= cnt[i]; w = i + 1; } }
    const float* src; bf16_t* dst; int K, Nsrc, Ndst, Nvalid, mode;
    conv_desc(p, l, w, src, dst, K, Nsrc, Ndst, Nvalid, mode);
    const int kts = K >> 6, kg = (kts + 3) >> 2, nt = r / kg, kq = r % kg, k0 = kq * 256;
    const int ntl = (kts - 4 * kq) < 4 ? (kts - 4 * kq) : 4;
    LAS float* tile = (LAS float*)(LAS char*)smem;
    {
        const int rr = tid & 63, ks = tid >> 6;
        const int rd = nt * 64 + rr; int sc;
        if (mode == 1) { const int t = rd >> 7, q = rd & 127, wc = q >> 6, j = (q & 63) >> 4, i = q & 15; sc = (j & 1) * 2816 + t * 64 + wc * 32 + (j >> 1) * 16 + i; }
        else sc = rd;
        const bool ok = rd < Nvalid;
        const float* sp = src + (size_t)(k0 + ks) * Nsrc + (ok ? sc : 0);
        float v[4][16];
#pragma unroll
        for (int t = 0; t < 4; ++t)
#pragma unroll
            for (int e = 0; e < 16; ++e) v[t][e] = (ok && t < ntl) ? sp[(size_t)(64 * t + 4 * e) * Nsrc] : 0.f;
#pragma unroll
        for (int t = 0; t < 4; ++t)
#pragma unroll
            for (int e = 0; e < 16; ++e) tile[t * 4160 + (ks + 4 * e) * 65 + rr] = v[t][e];
    }
    __syncthreads();
    {
        const int rr = tid >> 2, kc = (tid & 3) * 16;
#pragma unroll
        for (int t = 0; t < 4; ++t) {
            if (t < ntl) {
                const LAS float* tl = tile + t * 4160;
                u32x4 w0, w1;
                w0.x = cvtpk(tl[(kc + 0) * 65 + rr], tl[(kc + 1) * 65 + rr]); w0.y = cvtpk(tl[(kc + 2) * 65 + rr], tl[(kc + 3) * 65 + rr]);
                w0.z = cvtpk(tl[(kc + 4) * 65 + rr], tl[(kc + 5) * 65 + rr]); w0.w = cvtpk(tl[(kc + 6) * 65 + rr], tl[(kc + 7) * 65 + rr]);
                w1.x = cvtpk(tl[(kc + 8) * 65 + rr], tl[(kc + 9) * 65 + rr]); w1.y = cvtpk(tl[(kc + 10) * 65 + rr], tl[(kc + 11) * 65 + rr]);
                w1.z = cvtpk(tl[(kc + 12) * 65 + rr], tl[(kc + 13) * 65 + rr]); w1.w = cvtpk(tl[(kc + 14) * 65 + rr], tl[(kc + 15) * 65 + rr]);
                bf16_t* d = dst + (size_t)(nt * 64 + rr) * K + k0 + 64 * t + kc;
                *(u32x4*)d = w0; *(u32x4*)(d + 8) = w1;
            }
        }
    }
}
__device__ __forceinline__ void p0_copy(const Params& p, int it) {
    const int tid = ltid();
    const size_t base = (size_t)it * 8192;
    const float* src = base < (size_t)4194304 ? KIN(x_prompt) + base : KIN(x_sample) + (base - 4194304);
    float* dst = p.out + OUT_Y + base;
#pragma unroll
    for (int i = 0; i < 8; ++i) *(f32x4*)(dst + (i * 256 + tid) * 4) = *(const f32x4*)(src + (i * 256 + tid) * 4);
}

__device__ __forceinline__ void normmod_item(const Params& p, int l, int which  , int it) {
    const int tid = ltid(), w = tid >> 6, lane = tid & 63, row0 = it * 16 + w * 4;
    float* x = p.out + OUT_Y + (size_t)row0 * 1024;
    f32x4 v[4][4]; float ss[4];
#pragma unroll
    for (int j = 0; j < 4; ++j)
#pragma unroll
        for (int i = 0; i < 4; ++i) v[j][i] = *(const f32x4*)(x + j * 1024 + (i * 64 + lane) * 4);
#pragma unroll
    for (int j = 0; j < 4; ++j) {
        float a = 0.f;
#pragma unroll
        for (int i = 0; i < 4; ++i) a += v[j][i][0] * v[j][i][0] + v[j][i][1] * v[j][i][1] + v[j][i][2] * v[j][i][2] + v[j][i][3] * v[j][i][3];
        ss[j] = a;
    }
#pragma unroll
    for (int m = 32; m >= 1; m >>= 1)
#pragma unroll
        for (int j = 0; j < 4; ++j) ss[j] += shx(ss[j], m, lane);
    if (which == 3) {
        const float* fn = KIN(final_norm);
#pragma unroll
        for (int i = 0; i < 4; ++i) {
            const int c = (i * 64 + lane) * 4; const f32x4 g = *(const f32x4*)(fn + c);
#pragma unroll
            for (int j = 0; j < 4; ++j) { const float rs = rsqrtf(ss[j] * (1.f / 1024.f) + NEPS); *(f32x4*)(x + j * 1024 + c) = v[j][i] * rs * g; }
        }
        return;
    }
    const float* gain = (which == 0 ? KIN(norm_ffn1) : which == 1 ? KIN(norm_mix) : KIN(norm_ffn2)) + (size_t)l * 1024;
    const float* mod = (const float*)(p.ws + OFF_MOD) + ((size_t)l * 3 + modrow(row0)) * 9216 + which * 3072;
    bf16_t* h = (bf16_t*)(p.ws + OFF_H) + (size_t)row0 * 1024;
#pragma unroll
    for (int i = 0; i < 4; ++i) {
        const int c = (i * 64 + lane) * 4; const f32x4 g = *(const f32x4*)(gain + c), sh = *(const f32x4*)(mod + c), sc = *(const f32x4*)(mod + 1024 + c);
#pragma unroll
        for (int j = 0; j < 4; ++j) {
            const float rs = rsqrtf(ss[j] * (1.f / 1024.f) + NEPS);
            const f32x4 o = v[j][i] * rs * g * (sc + 1.f) + sh; u32x2 pk; pk.x = cvtpk(o[0], o[1]); pk.y = cvtpk(o[2], o[3]); *(u32x2*)(h + j * 1024 + c) = pk;
        }
    }
}

enum { EPI_SWIGLU = 0, EPI_RESID = 1, EPI_BF16 = 2, EPI_KV = 3 };
struct EpiArgs { void* out; int ld; const float* gate; float scale; };

template <int EPI>
__device__ __forceinline__ void gemm_tile(const bf16_t* __restrict__ A, int lda, const bf16_t* __restrict__ Bt, int K, int tm, int tn, const EpiArgs e, char* smem) {
    const int tid = ltid(), wave = tid >> 6, lane = tid & 63, wr = wave >> 1, wc = wave & 1, fr = lane & 15, fq = lane >> 4;
    const int m0 = tm * 128, n0 = tn * 128;
    f32x4 acc[4][4];
#pragma unroll
    for (int i = 0; i < 4; ++i)
#pragma unroll
        for (int j = 0; j < 4; ++j) acc[i][j] = (f32x4){0.f, 0.f, 0.f, 0.f};
    LAS char* ls = (LAS char*)smem;
    const int lr = lane >> 3, sch = (lane & 7) ^ lr;
    const bf16_t* ga = A + (size_t)(m0 + wave * 32 + lr) * lda + sch * 8;
    const bf16_t* gb = Bt + (size_t)(n0 + wave * 32 + lr) * K + sch * 8;
    const int nk = K >> 6;
#define GEMM_STAGE(buf, k0) do { _Pragma("unroll") for (int _i = 0; _i < 4; ++_i) { \
        __builtin_amdgcn_global_load_lds((const unsigned*)(ga + (size_t)_i * 8 * lda + (k0)), (LAS unsigned*)(ls + (buf) * 32768 + wave * 4096 + _i * 1024), 16, 0, 0); \
        __builtin_amdgcn_global_load_lds((const unsigned*)(gb + (size_t)_i * 8 * K + (k0)), (LAS unsigned*)(ls + (buf) * 32768 + 16384 + wave * 4096 + _i * 1024), 16, 0, 0); } } while (0)
    GEMM_STAGE(0, 0);
    __syncthreads();
    for (int kt = 0; kt < nk; ++kt) {
        const int cur = kt & 1;
        if (kt + 1 < nk) GEMM_STAGE(cur ^ 1, (kt + 1) * 64);
        const LAS char* sA = ls + cur * 32768; const LAS char* sB = sA + 16384;
#pragma unroll
        for (int ks = 0; ks < 2; ++ks) {
            bf16x8 af[4], bfr[4];
#pragma unroll
            for (int i = 0; i < 4; ++i) {
                const int ar = wr * 64 + i * 16 + fr, br = wc * 64 + i * 16 + fr, ch = ks * 4 + fq;
                af[i] = *(const LAS bf16x8*)(sA + ar * 128 + ((ch ^ (ar & 7)) << 4));
                bfr[i] = *(const LAS bf16x8*)(sB + br * 128 + ((ch ^ (br & 7)) << 4));
            }
            __builtin_amdgcn_s_setprio(1);
#pragma unroll
            for (int i = 0; i < 4; ++i)
#pragma unroll
                for (int j = 0; j < 4; ++j) acc[i][j] = MFMA16(bfr[j], af[i], acc[i][j]);
            __builtin_amdgcn_s_setprio(0);
        }
        __syncthreads();
    }
#undef GEMM_STAGE
#pragma unroll
    for (int i = 0; i < 4; ++i) {
        const int row = m0 + wr * 64 + i * 16 + fr;
        asm volatile("" ::: "memory");
        if (EPI == EPI_SWIGLU) {
            bf16_t* o = (bf16_t*)e.out + (size_t)row * DFF + tn * 64 + wc * 32 + 4 * fq;
#pragma unroll
            for (int pp = 0; pp < 2; ++pp) {
                const f32x4 g = acc[i][2 * pp], u = acc[i][2 * pp + 1];
                u32x2 pk; pk.x = cvtpk(siluf(g[0]) * u[0], siluf(g[1]) * u[1]); pk.y = cvtpk(siluf(g[2]) * u[2], siluf(g[3]) * u[3]);
                *(u32x2*)(o + pp * 16) = pk;
            }
        } else if (EPI == EPI_RESID) {
            float* x = (float*)e.out + (size_t)row * 1024;
            const float* g = e.gate + (size_t)modrow(row) * 9216;
#pragma unroll
            for (int j = 0; j < 4; ++j) {
                const int col = n0 + wc * 64 + j * 16 + 4 * fq;
                const f32x4 gv = *(const f32x4*)(g + col); f32x4 xv = *(const f32x4*)(x + col);
                xv = xv + gv * acc[i][j] * e.scale; *(f32x4*)(x + col) = xv;
            }
        } else if (EPI == EPI_BF16) {
            bf16_t* o = (bf16_t*)e.out + (size_t)row * e.ld;
#pragma unroll
            for (int j = 0; j < 4; ++j) {
                const int col = n0 + wc * 64 + j * 16 + 4 * fq;
                u32x2 pk; pk.x = cvtpk(acc[i][j][0], acc[i][j][1]); pk.y = cvtpk(acc[i][j][2], acc[i][j][3]); *(u32x2*)(o + col) = pk;
            }
        } else {
            size_t prow;
            int hstride;
            if (row < 4096) { prow = (size_t)(row >> 8) * 8 * 256 + (row & 255); hstride = 256; }
            else if (row < 8192) { const int r2 = row - 4096; prow = 32768 + (size_t)(r2 >> 11) * 8 * 2560 + (r2 & 2047); hstride = 2560; }
            else { const int r2 = row - 8192; prow = 32768 + (size_t)(r2 >> 9) * 8 * 2560 + 2048 + (r2 & 511); hstride = 2560; }
            bf16_t* Kp = (bf16_t*)(((Params*)e.out)->ws + OFF_KMLA); bf16_t* Vp = (bf16_t*)(((Params*)e.out)->ws + OFF_VMLA);
#pragma unroll
            for (int j = 0; j < 4; ++j) {
                const int col = n0 + wc * 64 + j * 16 + 4 * fq; const int hd = col >> 7, wi = col & 127;
                u32x2 pk; pk.x = cvtpk(acc[i][j][0], acc[i][j][1]); pk.y = cvtpk(acc[i][j][2], acc[i][j][3]);
                const size_t pr = prow + (size_t)hd * hstride;
                if (wi < 64) *(u32x2*)(Kp + pr * 96 + wi) = pk; else *(u32x2*)(Vp + pr * 64 + (wi - 64)) = pk;
            }
        }
    }
}

__device__ __forceinline__ void f1_token(const Params& p, int l, int tok, int lane) {
    const bf16_t* ur = (const bf16_t*)(p.ws + OFF_R1) + (size_t)tok * UW;
    const bool lat = tok >= NCTX;
    int b, s, T;
    if (!lat) { b = tok >> 8; s = tok & 255; T = 256; } else { b = (tok - NCTX) >> 11; s = (tok - NCTX) & 2047; T = 2048; }
    const float prow_ = (float)(s >> 6), pcol_ = (float)(s & 63);
    bf16_t* Kmla = (bf16_t*)(p.ws + OFF_KMLA);
    bf16_t pl_cq[6], pl_kv[4], pl_kr[2], pl_sq[8], pl_sk[2], pl_sv[2], pl_gz[8], pl_gt[2];
    {
        const int l16 = lane & 15, ksec = l16 >> 3, kj = l16 & 7;
#pragma unroll
        for (int i = 0; i < 6; ++i) pl_cq[i] = ur[U_CQ + lane + 64 * i];
#pragma unroll
        for (int i = 0; i < 4; ++i) pl_kv[i] = ur[U_CKV + lane + 64 * i];
        pl_kr[0] = ur[U_KR + ksec * 16 + kj]; pl_kr[1] = ur[U_KR + ksec * 16 + kj + 8];
#pragma unroll
        for (int i = 0; i < 4; ++i) { const int P = lane + 64 * i, head = P >> 5, pi = P & 31, sec = pi >> 4, j = pi & 15, base = head * 64 + sec * 32 + j; pl_sq[2 * i] = ur[U_SQ + base]; pl_sq[2 * i + 1] = ur[U_SQ + base + 16]; }
        { const int kvh = lane >> 5, pi = lane & 31, sec = pi >> 4, j = pi & 15, base = kvh * 64 + sec * 32 + j; pl_sk[0] = ur[U_SK + base]; pl_sk[1] = ur[U_SK + base + 16]; }
        pl_sv[0] = ur[U_SV + lane]; pl_sv[1] = ur[U_SV + 64 + lane];
#pragma unroll
        for (int i = 0; i < 8; ++i) pl_gz[i] = ur[U_GZ + lane + 64 * i];
        pl_gt[0] = ur[U_GATE + (lane & 7)]; pl_gt[1] = ur[U_GATE + 8 + (lane & 7)];
    }
    {
        float v[6]; float ss = 0.f;
#pragma unroll
        for (int i = 0; i < 6; ++i) { v[i] = bf2f(pl_cq[i]); ss += v[i] * v[i]; }
        ss = wave_sum(ss, lane); const float rs = rsqrtf(ss * (1.f / 384.f) + NEPS);
        bf16_t* o = (bf16_t*)(p.ws + OFF_CQN) + (size_t)tok * 384;
#pragma unroll
        for (int i = 0; i < 6; ++i) o[lane + 64 * i] = f2bf(v[i] * rs * KIN(mla_q_norm)[l * 384 + lane + 64 * i]);
    }
    {
        float v[4]; float ss = 0.f;
#pragma unroll
        for (int i = 0; i < 4; ++i) { v[i] = bf2f(pl_kv[i]); ss += v[i] * v[i]; }
        ss = wave_sum(ss, lane); const float rs = rsqrtf(ss * (1.f / 256.f) + NEPS);
        bf16_t* o = (bf16_t*)(p.ws + OFF_CKVA) + (size_t)tok * 256;
#pragma unroll
        for (int i = 0; i < 4; ++i) {
            const float val = v[i] * rs * KIN(mla_kv_norm)[l * 256 + lane + 64 * i];
            o[lane + 64 * i] = f2bf(val);
            if (!lat) p.out[OUT_CKV + ((size_t)(b * 2 + l) * 256 + s) * 256 + lane + 64 * i] = val;
        }
    }
    if (lane < 16) {
        const int sec = lane >> 3, j = lane & 7;
        float a = bf2f(pl_kr[0]), bb = bf2f(pl_kr[1]);
        if (lat) {
            const float ang = (sec ? pcol_ : prow_) * exp2f(-(float)j * 1.6609640474f);
            const float cs = __cosf(ang), sn = __sinf(ang);
            const float a2 = a * cs - bb * sn, b2 = bb * cs + a * sn; a = a2; bb = b2;
        } else {
            float* o = p.out + OUT_KROPE + ((size_t)(b * 2 + l) * 256 + s) * 32 + sec * 16 + j; o[0] = a; o[8] = bb;
        }
        const bf16_t ab = f2bf(a), bbb = f2bf(bb);
#pragma unroll
        for (int h = 0; h < 8; ++h) {
            const size_t pr = lat ? 32768 + (size_t)(b * 8 + h) * 2560 + s : (size_t)(b * 8 + h) * 256 + s;
            Kmla[pr * 96 + 64 + sec * 16 + j] = ab; Kmla[pr * 96 + 64 + sec * 16 + j + 8] = bbb;
        }
    }
    {
        bf16_t* Q = (bf16_t*)(p.ws + OFF_QSWA) + (size_t)tok * 512;
#pragma unroll
        for (int i = 0; i < 4; ++i) {
            const int P = lane + 64 * i, head = P >> 5, pi = P & 31, sec = pi >> 4, j = pi & 15, base = head * 64 + sec * 32 + j;
            float a = bf2f(pl_sq[2 * i]), bb = bf2f(pl_sq[2 * i + 1]);
            if (lat) {
                const float ang = (sec ? pcol_ : prow_) * exp2f(-(float)j * 0.830482024f);
                const float cs = __cosf(ang), sn = __sinf(ang);
                const float a2 = a * cs - bb * sn, b2 = bb * cs + a * sn; a = a2; bb = b2;
            }
            Q[base] = f2bf(a); Q[base + 16] = f2bf(bb);
        }
    }
    {
        const int kvh = lane >> 5, pi = lane & 31, sec = pi >> 4, j = pi & 15, base = kvh * 64 + sec * 32 + j;
        float a = bf2f(pl_sk[0]), bb = bf2f(pl_sk[1]);
        if (lat) {
            const float ang = (sec ? pcol_ : prow_) * exp2f(-(float)j * 0.830482024f);
            const float cs = __cosf(ang), sn = __sinf(ang);
            const float a2 = a * cs - bb * sn, b2 = bb * cs + a * sn; a = a2; bb = b2;
        } else {
            float* o = p.out + OUT_SWAK + (((size_t)(b * 2 + l) * 256 + s) * 2 + kvh) * 64 + sec * 32 + j; o[0] = a; o[16] = bb;
        }
        const size_t pr = lat ? 8192 + (size_t)(b * 2 + kvh) * 2560 + s : (size_t)(b * 2 + kvh) * 256 + s;
        bf16_t* Kp = (bf16_t*)(p.ws + OFF_KSWA) + pr * 64 + sec * 32 + j; Kp[0] = f2bf(a); Kp[16] = f2bf(bb);
    }
#pragma unroll
    for (int kvh = 0; kvh < 2; ++kvh) {
        const float v = bf2f(pl_sv[kvh]);
        const size_t pr = lat ? 8192 + (size_t)(b * 2 + kvh) * 2560 + s : (size_t)(b * 2 + kvh) * 256 + s;
        ((bf16_t*)(p.ws + OFF_VSWA))[pr * 64 + lane] = f2bf(v);
        if (!lat) p.out[OUT_SWAV + (((size_t)(b * 2 + l) * 256 + s) * 2 + kvh) * 64 + lane] = v;
    }
    {
        bf16_t* gz = (bf16_t*)(p.ws + OFF_GZ) + (size_t)tok * 512;
#pragma unroll
        for (int i = 0; i < 8; ++i) gz[lane + 64 * i] = pl_gz[i];
    }
    if (lane < 8) {
        const float ga = bf2f(pl_gt[0]), gb = bf2f(pl_gt[1]);
        const float xx = ga + KIN(gdn_dt_bias)[l * 8 + lane];
        const float sp = xx > 20.f ? xx : __logf(1.f + __expf(xx));
        ((float*)(p.ws + OFF_GG))[(size_t)tok * 8 + lane] = -__expf(KIN(gdn_a_log)[l * 8 + lane]) * sp;
        ((float*)(p.ws + OFF_GB))[(size_t)tok * 8 + lane] = 1.f / (1.f + __expf(-gb));
    }
}
__device__ __forceinline__ void f1_conv(const Params& p, int l, int blk, int wave, int lane) {
    const int tok0 = blk * 16;
    const bool lat = tok0 >= NCTX;
    const int s0 = lat ? ((tok0 - NCTX) & 2047) : (tok0 & 255), T = lat ? 2048 : 256;
    const bf16_t* ub = (const bf16_t*)(p.ws + OFF_R1) + (size_t)tok0 * UW + U_GQKV;
    const float* cw = KIN(gdn_conv_w) + (size_t)l * 5 * 1536;
    bf16_t* gq = (bf16_t*)(p.ws + OFF_GQ) + (size_t)tok0 * 512;
    float* gk = (float*)(p.ws + OFF_GK) + (size_t)tok0 * 512;
    float* gv = (float*)(p.ws + OFF_GV) + (size_t)tok0 * 512;
    for (int hi = 0; hi < 3; ++hi) {
        const int head = wave + 4 * hi, ch0 = head * 128 + lane, ch1 = ch0 + 64;
        float w0[5], w1[5], x0[5], x1[5];
#pragma unroll
        for (int jj = 0; jj < 5; ++jj) { w0[jj] = cw[jj * 1536 + ch0]; w1[jj] = cw[jj * 1536 + ch1]; }
#pragma unroll
        for (int jj = 0; jj < 4; ++jj) {
            const int sp = s0 + jj - 2; const bool ok = sp >= 0 && sp < T;
            x0[jj] = ok ? bf2f(ub[(ptrdiff_t)(jj - 2) * UW + ch0]) : 0.f; x1[jj] = ok ? bf2f(ub[(ptrdiff_t)(jj - 2) * UW + ch1]) : 0.f;
        }
        float y0[16], y1[16], ss[16];
#pragma unroll
        for (int t = 0; t < 16; ++t) {
            const int sp = s0 + t + 2; const bool ok = sp < T;
            x0[(t + 4) % 5] = ok ? bf2f(ub[(ptrdiff_t)(t + 2) * UW + ch0]) : 0.f; x1[(t + 4) % 5] = ok ? bf2f(ub[(ptrdiff_t)(t + 2) * UW + ch1]) : 0.f;
            float a0 = 0.f, a1 = 0.f;
#pragma unroll
            for (int jj = 0; jj < 5; ++jj) { a0 += w0[jj] * x0[(t + jj) % 5]; a1 += w1[jj] * x1[(t + jj) % 5]; }
            y0[t] = siluf(a0); y1[t] = siluf(a1); ss[t] = y0[t] * y0[t] + y1[t] * y1[t];
        }
        if (head < 8) {
#pragma unroll
            for (int m = 32; m >= 1; m >>= 1)
#pragma unroll
                for (int t = 0; t < 16; ++t) ss[t] += shx(ss[t], m, lane);
#pragma unroll
            for (int t = 0; t < 16; ++t) { const float rs = rsqrtf(ss[t] + 1e-6f); y0[t] *= rs; y1[t] *= rs; }
        }
#pragma unroll
        for (int t = 0; t < 16; ++t) {
            if (head < 4) { gq[t * 512 + ch0] = f2bf(y0[t]); gq[t * 512 + ch1] = f2bf(y1[t]); }
            else if (head < 8) { gk[t * 512 + ch0 - 512] = y0[t]; gk[t * 512 + ch1 - 512] = y1[t]; }
            else { gv[t * 512 + ch0 - 1024] = y0[t]; gv[t * 512 + ch1 - 1024] = y1[t]; }
        }
    }
}
__device__ __forceinline__ void f1_cache(const Params& p, int l, int idx, int lane) {
    const int b = idx >> 9, s = idx & 511;
    const size_t cb = (size_t)(b * 2 + l) * 512 + s;
    bf16_t* o = (bf16_t*)(p.ws + OFF_CKVA) + (size_t)(8192 + idx) * 256;
#pragma unroll
    for (int i = 0; i < 4; ++i) o[lane + 64 * i] = f2bf(KIN(c_mla_ckv)[cb * 256 + lane + 64 * i]);
    if (lane < 32) {
        const bf16_t v = f2bf(KIN(c_mla_krope)[cb * 32 + lane]);
#pragma unroll
        for (int h = 0; h < 8; ++h) ((bf16_t*)(p.ws + OFF_KMLA))[(32768 + (size_t)(b * 8 + h) * 2560 + 2048 + s) * 96 + 64 + lane] = v;
    }
#pragma unroll
    for (int kvh = 0; kvh < 2; ++kvh) {
        const size_t pr = 8192 + (size_t)(b * 2 + kvh) * 2560 + 2048 + s;
        ((bf16_t*)(p.ws + OFF_KSWA))[pr * 64 + lane] = f2bf(KIN(c_swa_k)[(cb * 2 + kvh) * 64 + lane]);
        ((bf16_t*)(p.ws + OFF_VSWA))[pr * 64 + lane] = f2bf(KIN(c_swa_v)[(cb * 2 + kvh) * 64 + lane]);
    }
}

__device__ __forceinline__ void cid_decode(int slot, int& R0, int& T, int& n) {
    if (slot < 64) { R0 = (slot >> 2) * 256; T = 256; n = slot & 3; } else { const int s2 = slot - 64; R0 = NCTX + (s2 >> 5) * 2048; T = 2048; n = s2 & 31; }
}
__device__ __forceinline__ void gdn_prep(const Params& p, int cid, char* smem) {
    const int tid = ltid(), h = cid & 3, slot = (cid >> 2) & 127, dir = cid >> 9;
    int R0, T, n; cid_decode(slot, R0, T, n);
    const int tbase = dir ? R0 + T - 1 - 64 * n : R0 + 64 * n, tstep = dir ? -1 : 1;
    LAS float* s_gc = (LAS float*)(LAS char*)smem; LAS float* s_beta = s_gc + 64; LAS float* s_eg = s_gc + 128;
    LAS float* s_L = s_gc + 192; LAS float* s_q = s_L + 4096; LAS float* s_k = s_q + 64 * 68;
    const bf16_t* gq = (const bf16_t*)(p.ws + OFF_GQ); const float* gk = (const float*)(p.ws + OFF_GK); const float* gv = (const float*)(p.ws + OFF_GV);
    if (tid < 64) {
        const int row = tbase + tstep * tid;
        float g = ((const float*)(p.ws + OFF_GG))[(size_t)row * 8 + dir * 4 + h];
        const float be = ((const float*)(p.ws + OFF_GB))[(size_t)row * 8 + dir * 4 + h];
#pragma unroll
        for (int d = 1; d < 64; d <<= 1) { const float t = __int_as_float(__builtin_amdgcn_ds_bpermute(((tid - d) & 63) << 2, __float_as_int(g))); if (tid >= d) g += t; }
        s_gc[tid] = g; s_beta[tid] = be; s_eg[tid] = __expf(g);
    }
    LAS char* lsb = (LAS char*)smem;
    constexpr int TQ = 17152, TST = 272, TKH = TQ + 64 * TST, TKL = TKH + 64 * TST;
    __syncthreads();
#pragma unroll
    for (int i = 0; i < 4; ++i) {
        const int c = tid + 256 * i, row = c >> 4, ch = c & 15; const size_t tok = (size_t)(tbase + tstep * row);
        *(LAS u32x4*)(lsb + TQ + row * TST + ch * 16) = *(const u32x4*)(gq + tok * 512 + h * 128 + ch * 8);
        const f32x4 k0 = *(const f32x4*)(gk + tok * 512 + h * 128 + ch * 8), k1 = *(const f32x4*)(gk + tok * 512 + h * 128 + ch * 8 + 4);
        u32x4 wh, wl;
        wh.x = cvtpk(k0[0], k0[1]); wh.y = cvtpk(k0[2], k0[3]); wh.z = cvtpk(k1[0], k1[1]); wh.w = cvtpk(k1[2], k1[3]);
        wl.x = cvtpk(k0[0] - __uint_as_float(wh.x << 16), k0[1] - __uint_as_float(wh.x & 0xffff0000u));
        wl.y = cvtpk(k0[2] - __uint_as_float(wh.y << 16), k0[3] - __uint_as_float(wh.y & 0xffff0000u));
        wl.z = cvtpk(k1[0] - __uint_as_float(wh.z << 16), k1[1] - __uint_as_float(wh.z & 0xffff0000u));
        wl.w = cvtpk(k1[2] - __uint_as_float(wh.w << 16), k1[3] - __uint_as_float(wh.w & 0xffff0000u));
        *(LAS u32x4*)(lsb + TKH + row * TST + ch * 16) = wh; *(LAS u32x4*)(lsb + TKL + row * TST + ch * 16) = wl;
    }
    __syncthreads();
    {
        const int wave = tid >> 6, lane = tid & 63, r = lane & 31, hh = lane >> 5, ti = wave >> 1, tj = wave & 1;
        f32x16 akk, aqk;
#pragma unroll
        for (int i = 0; i < 16; ++i) { akk[i] = 0.f; aqk[i] = 0.f; }
        const LAS char* ra = lsb + (32 * ti + r) * TST + 16 * hh; const LAS char* rb = lsb + (32 * tj + r) * TST + 16 * hh;
#pragma unroll
        for (int s8 = 0; s8 < 8; ++s8) {
            const bf16x8 akh = *(const LAS bf16x8*)(ra + TKH + 32 * s8), akl = *(const LAS bf16x8*)(ra + TKL + 32 * s8), aq = *(const LAS bf16x8*)(ra + TQ + 32 * s8);
            const bf16x8 bkh = *(const LAS bf16x8*)(rb + TKH + 32 * s8), bkl = *(const LAS bf16x8*)(rb + TKL + 32 * s8);
            akk = MFMA32(akh, bkh, akk); akk = MFMA32(akh, bkl, akk); akk = MFMA32(akl, bkh, akk);
            aqk = MFMA32(aq, bkh, aqk); aqk = MFMA32(aq, bkl, aqk);
        }
        const float qscale = 0.08838834764831845f;
        bf16_t* Ai = (bf16_t*)(p.ws + OFF_R1 + R1_AI) + (size_t)cid * 4096;
        const int j = 32 * tj + r; const float gcj = s_gc[j];
#pragma unroll
        for (int idx = 0; idx < 16; ++idx) {
            const int i = 32 * ti + rowmap(idx, hh);
            const float dec = (i >= j) ? __expf(s_gc[i] - gcj) : 0.f;
            s_L[i * 64 + j] = (i > j) ? s_beta[i] * akk[idx] * dec : 0.f;
            Ai[i * 64 + j] = f2bf(aqk[idx] * qscale * dec);
        }
    }
    __syncthreads();
    {
        const int c = tid;
        LAS float* xs = s_L + 4096;
        const float* src = (c < 128) ? (gv + h * 128 + c) : (gk + h * 128 + c - 128);
        bf16_t* Uo = (bf16_t*)(p.ws + OFF_R1 + R1_U) + (size_t)cid * 8192 + (c & 127) * 64;
        bf16_t* Wo = (bf16_t*)(p.ws + OFF_R1 + R1_WN) + (size_t)cid * 8192 + (c & 127);
#pragma unroll 1
        for (int I = 0; I < 4; ++I) {
            float xr[16];
#pragma unroll
            for (int rr = 0; rr < 16; ++rr) {
                const int i = 16 * I + rr;
                const float sc = (c < 128) ? s_beta[i] : s_beta[i] * s_eg[i];
                xr[rr] = sc * src[(size_t)(tbase + tstep * i) * 512];
            }
#pragma unroll 1
            for (int j4 = 0; j4 < 4 * I; ++j4) {
                const float xp0 = xs[(4 * j4) * 256 + c], xp1 = xs[(4 * j4 + 1) * 256 + c], xp2 = xs[(4 * j4 + 2) * 256 + c], xp3 = xs[(4 * j4 + 3) * 256 + c];
#pragma unroll
                for (int rr = 0; rr < 16; ++rr) {
                    const f32x4 Lv = *(const LAS f32x4*)(s_L + (16 * I + rr) * 64 + 4 * j4);
                    xr[rr] -= (Lv[0] * xp0 + Lv[2] * xp2) + (Lv[1] * xp1 + Lv[3] * xp3);
                }
            }
#pragma unroll
            for (int rr = 1; rr < 16; ++rr) {
                float a0 = 0.f, a1 = 0.f;
#pragma unroll
                for (int j4 = 0; j4 < (rr + 3) / 4; ++j4) {
                    const f32x4 Lv = *(const LAS f32x4*)(s_L + (16 * I + rr) * 64 + 16 * I + 4 * j4);
                    a0 += Lv[0] * xr[4 * j4] + Lv[2] * xr[4 * j4 + 2];
                    a1 += Lv[1] * xr[4 * j4 + 1] + Lv[3] * xr[4 * j4 + 3];
                }
                xr[rr] -= (a0 + a1);
            }
            if (I < 3) {
#pragma unroll
                for (int rr = 0; rr < 16; ++rr) xs[(16 * I + rr) * 256 + c] = xr[rr];
            }
            if (c < 128) {
                u32x4 w0, w1;
                w0.x = cvtpk(xr[0], xr[1]); w0.y = cvtpk(xr[2], xr[3]); w0.z = cvtpk(xr[4], xr[5]); w0.w = cvtpk(xr[6], xr[7]);
                w1.x = cvtpk(xr[8], xr[9]); w1.y = cvtpk(xr[10], xr[11]); w1.z = cvtpk(xr[12], xr[13]); w1.w = cvtpk(xr[14], xr[15]);
                *(u32x4*)(Uo + 16 * I) = w0; *(u32x4*)(Uo + 16 * I + 8) = w1;
            } else {
#pragma unroll
                for (int rr = 0; rr < 16; ++rr) Wo[(16 * I + rr) * 128] = f2bf(-xr[rr]);
            }
        }
    }
    const float gl = s_gc[63];
    bf16_t* KdT = (bf16_t*)(p.ws + OFF_R1 + R1_KDT) + (size_t)cid * 8192;
#pragma unroll
    for (int it = 0; it < 8; ++it) {
        const int w = tid + 256 * it, d = w & 127, p4 = w >> 7; float v[4];
#pragma unroll
        for (int e = 0; e < 4; ++e) { const int pp = 4 * p4 + e; v[e] = gk[(size_t)(tbase + tstep * pp) * 512 + h * 128 + d] * __expf(gl - s_gc[pp]); }
        u32x2 pk; pk.x = cvtpk(v[0], v[1]); pk.y = cvtpk(v[2], v[3]); *(u32x2*)(KdT + d * 64 + 4 * p4) = pk;
    }
    if (tid < 64) ((float*)(p.ws + OFF_EGQ))[(size_t)cid * 64 + tid] = 0.08838834764831845f * s_eg[tid];
    if (tid == 0) ((float*)(p.ws + OFF_GTOT))[cid] = __expf(gl);
}

#define SC_RW 0
#define SC_RQ 16384
#define SC_RK 32768
#define SC_RA 49152
#define SC_RU 57344
#define SC_RE 73728
__device__ __forceinline__ bf16x8 lds2x8(const LAS char* p0) { u32x2 a = *(const LAS u32x2*)p0, b = *(const LAS u32x2*)(p0 + 16); u32x4 w; w.x = a.x; w.y = a.y; w.z = b.x; w.w = b.y; return __builtin_bit_cast(bf16x8, w); }
__device__ __forceinline__ bf16x8 lds_sw(const LAS char* rowbase, int m16, int c) {
    const int o = m16 ^ (c << 4);
    u32x2 a = *(const LAS u32x2*)(rowbase + o), b = *(const LAS u32x2*)(rowbase + (o ^ 16)); u32x4 w; w.x = a.x; w.y = a.y; w.z = b.x; w.w = b.y; return __builtin_bit_cast(bf16x8, w);
}
__device__ __forceinline__ void gdn_scan(const Params& p, int l, int item, char* smem) {
    const int tid = ltid(), wave = tid >> 6, lane = tid & 63, r = lane & 31, hh = lane >> 5, dv = wave * 32 + r;
    LAS char* ls = (LAS char*)smem;
    const int h = item & 3, dir = (item >> 2) & 1, sqi = item >> 3;
    int R0, T, nch, slot0;
    if (sqi >= 2) { const int b = sqi - 2; R0 = b * 256; T = 256; nch = 4; slot0 = b * 4; } else { R0 = NCTX + sqi * 2048; T = 2048; nch = 32; slot0 = 64 + sqi * 32; }
    const unsigned loU = (unsigned)(4 * hh * 128 + dv), loO = (unsigned)((dir ? 4 - 4 * hh : 4 * hh) * 512 + dv);
    const bf16_t* gq = (const bf16_t*)(p.ws + OFF_GQ) + h * 128;
    float* odir = (float*)(p.ws + OFF_GK) + (size_t)dir * 8192 * 512 + h * 128;
    const int ra = lane >> 4, ca = lane & 15, rb = lane >> 3, cb = lane & 7;
    auto dma_g1 = [&](int n) {
        const int cid = (dir * 128 + slot0 + n) * 4 + h;
        const char* Wn = p.ws + OFF_R1 + R1_WN + (size_t)cid * 16384; const char* UT = p.ws + OFF_R1 + R1_U + (size_t)cid * 16384;
#pragma unroll
        for (int i = 0; i < 4; ++i) {
            const int pc = wave * 4 + i, rowa = 4 * pc + ra, rowb = 8 * pc + rb;
            __builtin_amdgcn_global_load_lds((const unsigned*)(Wn + rowa * 256 + ((ca ^ (rowa & 15)) << 4)), (LAS unsigned*)(ls + SC_RW + pc * 1024), 16, 0, 0);
            __builtin_amdgcn_global_load_lds((const unsigned*)(UT + rowb * 128 + ((cb ^ (rowb & 7)) << 4)), (LAS unsigned*)(ls + SC_RU + pc * 1024), 16, 0, 0);
        }
    };
    auto dma_g2 = [&](int n) {
        const int cid = (dir * 128 + slot0 + n) * 4 + h;
        const int tbase = dir ? R0 + T - 1 - 64 * n : R0 + 64 * n;
        const char* KdT = p.ws + OFF_R1 + R1_KDT + (size_t)cid * 16384; const char* Ai = p.ws + OFF_R1 + R1_AI + (size_t)cid * 8192;
#pragma unroll
        for (int i = 0; i < 4; ++i) {
            const int pc = wave * 4 + i, rowa = 4 * pc + ra, rowb = 8 * pc + rb;
            const int tok = dir ? tbase - rowa : tbase + rowa;
            __builtin_amdgcn_global_load_lds((const unsigned*)(gq + (size_t)tok * 512 + ((ca ^ (rowa & 15)) << 3)), (LAS unsigned*)(ls + SC_RQ + pc * 1024), 16, 0, 0);
            __builtin_amdgcn_global_load_lds((const unsigned*)(KdT + rowb * 128 + ((cb ^ (rowb & 7)) << 4)), (LAS unsigned*)(ls + SC_RK + pc * 1024), 16, 0, 0);
        }
#pragma unroll
        for (int i = 0; i < 2; ++i) {
            const int pc = wave * 2 + i, rowb = 8 * pc + rb;
            __builtin_amdgcn_global_load_lds((const unsigned*)(Ai + rowb * 128 + ((cb ^ (rowb & 7)) << 4)), (LAS unsigned*)(ls + SC_RA + pc * 1024), 16, 0, 0);
        }
        if (wave == 0) __builtin_amdgcn_global_load_lds((const unsigned*)((const float*)(p.ws + OFF_EGQ) + (size_t)cid * 64 + lane), (LAS unsigned*)(ls + SC_RE), 4, 0, 0);
    };
    __builtin_amdgcn_s_setprio(2);
    dma_g1(0); dma_g2(0);
    f32x16 S[4];
    if (sqi < 2) {
        const float* st = KIN(state_gdn) + ((((size_t)sqi * 2 + l) * 2 + dir) * 4 + h) * 16384;
#pragma unroll
        for (int t = 0; t < 4; ++t)
#pragma unroll
            for (int i = 0; i < 16; ++i) { const float* sb = st + (32 * t + (i & 3) + 8 * (i >> 2)) * 128; S[t][i] = sb[loU]; }
    } else {
#pragma unroll
        for (int t = 0; t < 4; ++t)
#pragma unroll
            for (int i = 0; i < 16; ++i) S[t][i] = 0.f;
    }
    __syncthreads();
    const int m16a = (r & 15) << 4, m16b = (r & 7) << 4;
    const LAS char* bW = ls + SC_RW + r * 256 + 8 * hh; const LAS char* bQ = ls + SC_RQ + r * 256 + 8 * hh;
    const LAS char* bA = ls + SC_RA + r * 128 + 8 * hh; const LAS char* bK = ls + SC_RK + r * 128 + 8 * hh;
    const LAS char* bU = ls + SC_RU + (32 * wave + r) * 128 + 8 * hh;
    for (int n = 0; n < nch; ++n) {
        const int cid = (dir * 128 + slot0 + n) * 4 + h;
        const int tbase = dir ? R0 + T - 1 - 64 * n : R0 + 64 * n;
        const float gt = ((const float*)(p.ws + OFF_GTOT))[cid];
        const bool more = n + 1 < nch;
        bf16x8 Vb[4];
        {
            f32x16 Vp[2];
#pragma unroll
            for (int rt = 0; rt < 2; ++rt)
#pragma unroll
                for (int g = 0; g < 4; ++g) {
                    const u32x2 w = *(const LAS u32x2*)(bU + (m16b ^ ((4 * rt + g) << 4)));
                    Vp[rt][4 * g] = __uint_as_float(w.x << 16); Vp[rt][4 * g + 1] = __uint_as_float(w.x & 0xffff0000u);
                    Vp[rt][4 * g + 2] = __uint_as_float(w.y << 16); Vp[rt][4 * g + 3] = __uint_as_float(w.y & 0xffff0000u);
                }
#pragma unroll
            for (int t = 0; t < 4; ++t)
#pragma unroll
                for (int ss = 0; ss < 2; ++ss) {
                    if (ss == 0) asm volatile("" ::: "memory");
                    const int o = ss * 8, s = 2 * t + ss;
                    const bf16x8 Sb = pack8(S[t][o], S[t][o + 1], S[t][o + 2], S[t][o + 3], S[t][o + 4], S[t][o + 5], S[t][o + 6], S[t][o + 7]);
#pragma unroll
                    for (int rt = 0; rt < 2; ++rt) Vp[rt] = MFMA32(lds_sw(bW + rt * 32 * 256, m16a, 2 * s), Sb, Vp[rt]);
                }
#pragma unroll
            for (int s2 = 0; s2 < 4; ++s2) { const int rt = s2 >> 1, o = (s2 & 1) * 8; Vb[s2] = pack8(Vp[rt][o], Vp[rt][o + 1], Vp[rt][o + 2], Vp[rt][o + 3], Vp[rt][o + 4], Vp[rt][o + 5], Vp[rt][o + 6], Vp[rt][o + 7]); }
        }
        __syncthreads();
        if (more) dma_g1(n + 1);
#pragma unroll
        for (int rt = 0; rt < 2; ++rt) {
            asm volatile("" ::: "memory");
            f32x16 O;
#pragma unroll
            for (int i = 0; i < 16; ++i) O[i] = 0.f;
#pragma unroll
            for (int t = 0; t < 4; ++t)
#pragma unroll
                for (int ss = 0; ss < 2; ++ss) {
                    if (ss == 0 && (t & 1) == 0) asm volatile("" ::: "memory");
                    const int o = ss * 8, s = 2 * t + ss;
                    const bf16x8 Sb = pack8(S[t][o], S[t][o + 1], S[t][o + 2], S[t][o + 3], S[t][o + 4], S[t][o + 5], S[t][o + 6], S[t][o + 7]);
                    O = MFMA32(lds_sw(bQ + rt * 32 * 256, m16a, 2 * s), Sb, O);
                }
#pragma unroll
            for (int i = 0; i < 16; ++i) O[i] *= *(const LAS float*)(ls + SC_RE + (32 * rt + rowmap(i, hh)) * 4);
#pragma unroll
            for (int s2 = 0; s2 < 4; ++s2) O = MFMA32(lds_sw(bA + rt * 32 * 128, m16b, 2 * s2), Vb[s2], O);
#pragma unroll
            for (int i = 0; i < 16; ++i) {
                const int k = 32 * rt + (i & 3) + 8 * (i >> 2);
                float* ob = odir + (size_t)(dir ? tbase - k - 4 : tbase + k) * 512;
                ob[loO] = O[i];
            }
        }
#pragma unroll
        for (int t = 0; t < 4; ++t) {
            asm volatile("" ::: "memory");
#pragma unroll
            for (int i = 0; i < 16; ++i) S[t][i] *= gt;
#pragma unroll
            for (int s2 = 0; s2 < 4; ++s2) S[t] = MFMA32(lds_sw(bK + t * 32 * 128, m16b, 2 * s2), Vb[s2], S[t]);
        }
        __syncthreads();
        if (more) dma_g2(n + 1);
    }
    if (sqi >= 2) {
        float* so = p.out + OUT_STATE + ((((size_t)(sqi - 2) * 2 + l) * 2 + dir) * 4 + h) * 16384;
#pragma unroll
        for (int t = 0; t < 4; ++t)
#pragma unroll
            for (int i = 0; i < 16; ++i) { float* sb = so + (32 * t + (i & 3) + 8 * (i >> 2)) * 128; sb[loU] = S[t][i]; }
    }
    __builtin_amdgcn_s_setprio(0);
}

template <int DQK>
__device__ __forceinline__ void attn_item(const Params& p, int l, int dom, int b, int h, int qt, char* smem) {
    constexpr bool MLA = (DQK == 96);
    constexpr int NS = DQK / 16, KST = (DQK + 8) * 2, VST = 144, NCH = DQK / 8, NLD = NCH * 64 / 256;
    const int tid = ltid(), wave = tid >> 6, lane = tid & 63, r = lane & 31, hh = lane >> 5;
    const int q0 = qt * 128, qpos = q0 + wave * 32 + r;
    const int tokq = (dom ? NCTX + b * 2048 : b * 256) + qpos;
    LAS char* sK = (LAS char*)smem; LAS char* sV = sK + 64 * KST;
    bf16x8 Qf[NS];
    {
        const bf16_t* Qp = MLA ? (const bf16_t*)(p.ws + OFF_QRAW) + (size_t)tokq * 768 + h * 96 : (const bf16_t*)(p.ws + OFF_QSWA) + (size_t)tokq * 512 + h * 64;
#pragma unroll
        for (int s = 0; s < NS; ++s) Qf[s] = *(const bf16x8*)(Qp + 16 * s + 8 * hh);
        if (MLA && dom) {
#pragma unroll
            for (int s = 4; s < NS; ++s) {
                const float pos = (s == 4) ? (float)(qpos >> 6) : (float)(qpos & 63);
                float o[8];
#pragma unroll
                for (int j = 0; j < 8; ++j) {
                    const float xa = bf2f((bf16_t)Qf[s][j]); const float xb = shx(xa, 32, lane);
                    const float ang = pos * exp2f(-(float)j * 1.6609640474f); const float cs = __cosf(ang), sn = __sinf(ang);
                    o[j] = hh ? xa * cs + xb * sn : xa * cs - xb * sn;
                }
                Qf[s] = pack8(o[0], o[1], o[2], o[3], o[4], o[5], o[6], o[7]);
            }
        }
    }
    const bf16_t *Kb, *Vb;
    float m, lsum, sc;
    int nb, t0, nx; bool band = false;
    if (MLA) {
        const size_t pr = dom ? 32768 + (size_t)(b * 8 + h) * 2560 : (size_t)(b * 8 + h) * 256;
        Kb = (const bf16_t*)(p.ws + OFF_KMLA) + pr * 96; Vb = (const bf16_t*)(p.ws + OFF_VMLA) + pr * 64;
        m = -INFINITY; lsum = 0.f; sc = 0.10206207261596577f * LOG2E; t0 = 0; nx = 0; nb = dom ? 40 : 4;
    } else {
        const int kvh = h >> 2; const size_t pr = dom ? 8192 + (size_t)(b * 2 + kvh) * 2560 : (size_t)(b * 2 + kvh) * 256;
        Kb = (const bf16_t*)(p.ws + OFF_KSWA) + pr * 64; Vb = (const bf16_t*)(p.ws + OFF_VSWA) + pr * 64;
        m = KIN(swa_sink)[l * 8 + h] * LOG2E; lsum = 1.f; sc = 0.125f * LOG2E;
        if (dom) { const int lo = (q0 - 128 > 0 ? q0 - 128 : 0) >> 6, hi = (q0 + 256 < 2048 ? q0 + 256 : 2048) >> 6; t0 = lo; nb = hi - lo; nx = 8; band = true; }
        else { t0 = 0; nb = 4; nx = 0; }
    }
    const int ntile = nb + nx;
    f32x16 oacc[2];
#pragma unroll
    for (int i = 0; i < 16; ++i) { oacc[0][i] = 0.f; oacc[1][i] = 0.f; }
    u32x4 rkA[NLD], rvA[2], rkB[NLD], rvB[2];
    auto key0_of = [&](int ti) { return ti < nb ? 64 * (t0 + ti) : 2048 + 64 * (ti - nb); };
    auto prefetch = [&](int ti, u32x4 (&rkc)[NLD], u32x4 (&rvc)[2]) {
        const int k0 = key0_of(ti);
#pragma unroll
        for (int i = 0; i < NLD; ++i) { const int c = tid + 256 * i, row = c / NCH, ch = c % NCH; rkc[i] = *(const u32x4*)(Kb + (size_t)(k0 + row) * DQK + ch * 8); }
#pragma unroll
        for (int i = 0; i < 2; ++i) { const int c = tid + 256 * i, key = c & 63, ch = c >> 6; rvc[i] = *(const u32x4*)(Vb + (size_t)(k0 + key) * 64 + ch * 8); }
    };
    auto step = [&](int ti, u32x4 (&rkc)[NLD], u32x4 (&rvc)[2]) {
        __syncthreads();
#pragma unroll
        for (int i = 0; i < NLD; ++i) { const int c = tid + 256 * i, row = c / NCH, ch = c % NCH; *(LAS u32x4*)(sK + row * KST + ch * 16) = rkc[i]; }
#pragma unroll
        for (int i = 0; i < 2; ++i) {
            const int c = tid + 256 * i, key = c & 63, ch = c >> 6; const unsigned w4[4] = {rvc[i].x, rvc[i].y, rvc[i].z, rvc[i].w};
#pragma unroll
            for (int e = 0; e < 4; ++e) {
                *(LAS bf16_t*)(sV + (ch * 8 + 2 * e) * VST + key * 2) = (bf16_t)(w4[e] & 0xffffu);
                *(LAS bf16_t*)(sV + (ch * 8 + 2 * e + 1) * VST + key * 2) = (bf16_t)(w4[e] >> 16);
            }
        }
        __syncthreads();
        const int k0 = key0_of(ti); const bool msk = band && ti < nb;
        if (ti + 2 < ntile) prefetch(ti + 2, rkc, rvc);
        f32x16 sacc[2];
        __builtin_amdgcn_s_setprio(1);
#pragma unroll
        for (int rt = 0; rt < 2; ++rt) {
#pragma unroll
            for (int i = 0; i < 16; ++i) sacc[rt][i] = 0.f;
#pragma unroll
            for (int s = 0; s < NS; ++s) { const bf16x8 kf = *(const LAS bf16x8*)(sK + (32 * rt + r) * KST + (16 * s + 8 * hh) * 2); sacc[rt] = MFMA32(kf, Qf[s], sacc[rt]); }
        }
        __builtin_amdgcn_s_setprio(0);
        float mx = -INFINITY;
#pragma unroll
        for (int rt = 0; rt < 2; ++rt)
#pragma unroll
            for (int i = 0; i < 16; ++i) {
                float v = sacc[rt][i] * sc;
                if (msk) { const int key = k0 + 32 * rt + rowmap(i, hh); const int d = qpos - key; if (d > 128 || d < -128) v = -INFINITY; }
                sacc[rt][i] = v; mx = fmaxf(mx, v);
            }
        mx = fmaxf(mx, shx(mx, 32, lane));
        const float mnew = fmaxf(m, mx), muse = (mnew == -INFINITY) ? 0.f : mnew;
        const float alpha = __builtin_amdgcn_exp2f(m - muse);
        float rs = 0.f;
#pragma unroll
        for (int rt = 0; rt < 2; ++rt)
#pragma unroll
            for (int i = 0; i < 16; ++i) { const float pv = __builtin_amdgcn_exp2f(sacc[rt][i] - muse); sacc[rt][i] = pv; rs += pv; }
        rs += shx(rs, 32, lane);
        lsum = lsum * alpha + rs; m = mnew;
#pragma unroll
        for (int i = 0; i < 16; ++i) { oacc[0][i] *= alpha; oacc[1][i] *= alpha; }
        __builtin_amdgcn_s_setprio(1);
#pragma unroll
        for (int s2 = 0; s2 < 4; ++s2) {
            const int rt = s2 >> 1, o = (s2 & 1) * 8;
            const bf16x8 pf = pack8(sacc[rt][o], sacc[rt][o + 1], sacc[rt][o + 2], sacc[rt][o + 3], sacc[rt][o + 4], sacc[rt][o + 5], sacc[rt][o + 6], sacc[rt][o + 7]);
#pragma unroll
            for (int dt = 0; dt < 2; ++dt) {
                oacc[dt] = MFMA32(lds2x8(sV + (32 * dt + r) * VST + (16 * s2 + 4 * hh) * 2), pf, oacc[dt]);
            }
        }
        __builtin_amdgcn_s_setprio(0);
    };
    prefetch(0, rkA, rvA);
    if (ntile > 1) prefetch(1, rkB, rvB);
    for (int ti = 0; ti < ntile; ti += 2) {
        step(ti, rkA, rvA);
        if (ti + 1 < ntile) step(ti + 1, rkB, rvB);
    }
    const float inv = 1.f / lsum;
    bf16_t* mix = (bf16_t*)(p.ws + OFF_H) + (size_t)tokq * 1536 + (MLA ? 0 : 512) + h * 64;
#pragma unroll
    for (int dt = 0; dt < 2; ++dt)
#pragma unroll
        for (int g = 0; g < 4; ++g) {
            u32x2 pk; pk.x = cvtpk(oacc[dt][4 * g] * inv, oacc[dt][4 * g + 1] * inv); pk.y = cvtpk(oacc[dt][4 * g + 2] * inv, oacc[dt][4 * g + 3] * inv);
            *(u32x2*)(mix + 32 * dt + 8 * g + 4 * hh) = pk;
        }
}

__device__ __forceinline__ void gdn_post(const Params& p, int l, int tok0, int lane) {
    const float* gn = KIN(gdn_norm) + l * 128;
    const float g0 = gn[lane], g1 = gn[lane + 64];
    float v0[4][4], v1[4][4], z0[4][4], z1[4][4];
#pragma unroll
    for (int j = 0; j < 4; ++j) {
        const float* of = (const float*)(p.ws + OFF_GK) + (size_t)(tok0 + j) * 512; const float* ob = of + (size_t)8192 * 512;
        const bf16_t* gz = (const bf16_t*)(p.ws + OFF_GZ) + (size_t)(tok0 + j) * 512;
#pragma unroll
        for (int hd = 0; hd < 4; ++hd) {
            const int c0 = hd * 128 + lane, c1 = c0 + 64;
            v0[j][hd] = of[c0] + ob[c0]; v1[j][hd] = of[c1] + ob[c1]; z0[j][hd] = bf2f(gz[c0]); z1[j][hd] = bf2f(gz[c1]);
        }
    }
#pragma unroll
    for (int j = 0; j < 4; ++j) {
        bf16_t* mix = (bf16_t*)(p.ws + OFF_H) + (size_t)(tok0 + j) * 1536 + 1024;
        float ss[4];
#pragma unroll
        for (int hd = 0; hd < 4; ++hd) ss[hd] = v0[j][hd] * v0[j][hd] + v1[j][hd] * v1[j][hd];
#pragma unroll
        for (int m = 32; m >= 1; m >>= 1)
#pragma unroll
            for (int hd = 0; hd < 4; ++hd) ss[hd] += shx(ss[hd], m, lane);
#pragma unroll
        for (int hd = 0; hd < 4; ++hd) {
            const float rs = rsqrtf(ss[hd] * (1.f / 128.f) + NEPS);
            mix[hd * 128 + lane] = f2bf(v0[j][hd] * rs * g0 * siluf(z0[j][hd]));
            mix[hd * 128 + lane + 64] = f2bf(v1[j][hd] * rs * g1 * siluf(z1[j][hd]));
        }
    }
}

__host__ __device__ constexpr int kind_items(int q) {
    switch (q) {
        case 0: case 3: case 10: return 512;
        case 1: case 11: return 64 * 44;
        case 2: case 12: return 64 * 8;
        case 4: return 64 * 28;
        case 5: return 512 + 2048 + 256;
        case 6: return 1024 + 384 + 576;
        case 7: return 144 + 1024;
        case 8: return 512;
        case 9: return 64 * 8;
        case 13: return 144 + CONV_PER_LAYER + 1024;
        default: return 512;
    }
}
template <int Q>
__device__ __forceinline__ void run_item(const Params& p, int l, int item, char* smem) {
    const int tid = ltid(), wave = tid >> 6, lane = tid & 63;
    char* wb = p.ws + OFF_W + (size_t)l * LAYER_W;
    const float* mod = (const float*)(p.ws + OFF_MOD) + (size_t)l * 3 * 9216;
    EpiArgs e; e.out = nullptr; e.ld = 0; e.gate = nullptr; e.scale = 1.f;
    if constexpr (Q == 13) {
        if (item < 144) p0_ada(p, item, smem);
        else if (item < 144 + CONV_PER_LAYER) p0_conv(p, item - 144, smem);
        else p0_copy(p, item - 144 - CONV_PER_LAYER);
    } else if constexpr (Q == 14) { normmod_item(p, 0, 3, item);
    } else if constexpr (Q == 0) { normmod_item(p, l, 0, item);
    } else if constexpr (Q == 3) { normmod_item(p, l, 1, item);
    } else if constexpr (Q == 10) { normmod_item(p, l, 2, item);
    } else if constexpr (Q == 1 || Q == 11) {
        e.out = p.ws + OFF_R1;
        gemm_tile<EPI_SWIGLU>((const bf16_t*)(p.ws + OFF_H), 1024, (const bf16_t*)(wb + (Q == 1 ? WO_W1A : WO_W1B)), 1024, item & 63, item >> 6, e, smem);
    } else if constexpr (Q == 2 || Q == 12) {
        e.out = p.out + OUT_Y; e.gate = mod + (Q == 2 ? 2 : 8) * 1024; e.scale = 0.5f;
        gemm_tile<EPI_RESID>((const bf16_t*)(p.ws + OFF_R1), DFF, (const bf16_t*)(wb + (Q == 2 ? WO_W2A : WO_W2B)), DFF, item & 63, item >> 6, e, smem);
    } else if constexpr (Q == 4) {
        e.out = p.ws + OFF_R1; e.ld = UW;
        gemm_tile<EPI_BF16>((const bf16_t*)(p.ws + OFF_H), 1024, (const bf16_t*)(wb + WO_WIN), 1024, item & 63, item >> 6, e, smem);
    } else if constexpr (Q == 5) {
        if (item < 512) f1_conv(p, l, item, wave, lane); else if (item < 2560) f1_token(p, l, (item - 512) * 4 + wave, lane); else f1_cache(p, l, (item - 2560) * 4 + wave, lane);
    } else if constexpr (Q == 6) {
        if (item < 1024) gdn_prep(p, item, smem);
        else if (item < 1024 + 384) { const int t = item - 1024; e.out = p.ws + OFF_QRAW; e.ld = 768;
            gemm_tile<EPI_BF16>((const bf16_t*)(p.ws + OFF_CQN), 384, (const bf16_t*)(wb + WO_WQB), 384, t & 63, t >> 6, e, smem); }
        else { const int t = item - 1408; e.out = (void*)&p;
            gemm_tile<EPI_KV>((const bf16_t*)(p.ws + OFF_CKVA), 256, (const bf16_t*)(wb + WO_WKVB), 256, t % 72, t / 72, e, smem); }
    } else if constexpr (Q == 7) {
        const int aoff = (l == 0) ? 288 : 144;
        if (item < 144) gdn_scan(p, l, item, smem);
        else if (item < aoff) p0_ada(p, item, smem);
        else if (item >= aoff + 1024) p0_conv(p, CONV_PER_LAYER + (item - aoff - 1024), smem);
        else {
            const int a = item - aoff, grp = a >> 8, i = a & 255;
            if (grp == 0) attn_item<96>(p, l, 1, i >> 7, (i >> 4) & 7, i & 15, smem);
            else if (grp == 1) attn_item<64>(p, l, 1, i >> 7, (i >> 4) & 7, i & 15, smem);
            else if (grp == 2) attn_item<96>(p, l, 0, i >> 4, (i >> 1) & 7, i & 1, smem);
            else attn_item<64>(p, l, 0, i >> 4, (i >> 1) & 7, i & 1, smem);
        }
    } else if constexpr (Q == 8) { gdn_post(p, l, item * 16 + wave * 4, lane);
    } else {
        e.out = p.out + OUT_Y; e.gate = mod + 5 * 1024; e.scale = 1.f;
        gemm_tile<EPI_RESID>((const bf16_t*)(p.ws + OFF_H), 1536, (const bf16_t*)(wb + WO_WOUT), 1536, item & 63, item >> 6, e, smem);
    }
}

template <int Q>
__global__ void __launch_bounds__(256, 2) k_phase(Params p, int l) {
    __shared__ __attribute__((aligned(16))) char smem[SMEM_BYTES];
    run_item<Q>(p, l, blockIdx.x, smem);
}

#if MEGA

#define XB_TMO      128
#define XB_XCNT(j)  (256  + 64 * (j))
#define XB_XSUB(j)  (1280 + 64 * (j))
#define XB_XGEN(j)  (2304 + 64 * (j))
#define XB_TOP      3328
#define XB_TOPGEN   3392
#define XCD_BAR_WORDS 3456
#define CTR_WORD0   3584
#define XB_SPIN_CAP (1u << 18)
__device__ __forceinline__ unsigned xb_ld(unsigned* p)              { return __hip_atomic_load(p, __ATOMIC_RELAXED, __HIP_MEMORY_SCOPE_AGENT); }
__device__ __forceinline__ unsigned xb_add(unsigned* p, unsigned v) { return __hip_atomic_fetch_add(p, v, __ATOMIC_RELAXED, __HIP_MEMORY_SCOPE_AGENT); }
__device__ __forceinline__ unsigned xb_xcc_id() { return (unsigned)__builtin_amdgcn_s_getreg((3 << 11) | 20) & 0xFu; }
#define XB_SPIN(cond, bar) do { unsigned _sp = 0; while (cond) { __builtin_amdgcn_s_sleep(1); \
    if ((++_sp & 255u) == 0u) { if (xb_ld(&(bar)[XB_TMO])) break; if (_sp > XB_SPIN_CAP) { atomicAdd(&(bar)[XB_TMO], 1u); break; } } } } while (0)
struct XcdBarrier { unsigned* bar; unsigned x; volatile LAS unsigned* st; };
__device__ __forceinline__ XcdBarrier xcd_barrier_post(unsigned* bar, volatile LAS unsigned* st) {
    XcdBarrier b; b.bar = bar; b.x = xb_xcc_id(); b.st = st;
    if (ltid() == 0) (void)xb_add(&bar[XB_XCNT(b.x)], 1u);
    return b;
}
__device__ __forceinline__ void xcd_barrier_complete(unsigned* bar, unsigned x, unsigned& nloc, unsigned& nx) {
    const unsigned G = gridDim.x * gridDim.y * gridDim.z;
    unsigned sum, cnt, mine, sp = 0u;
    for (;;) {
        sum = 0u; cnt = 0u; mine = 0u;
#pragma unroll
        for (unsigned j = 0; j < 16; ++j) { const unsigned c = xb_ld(&bar[XB_XCNT(j)]); sum += c; cnt += (c > 0u) ? 1u : 0u; mine = (j == x) ? c : mine; }
        if (sum == G) break;
        __builtin_amdgcn_s_sleep(1);
        if ((++sp & 255u) == 0u) { if (xb_ld(&bar[XB_TMO])) break; if (sp > XB_SPIN_CAP) { atomicAdd(&bar[XB_TMO], 1u); break; } }
    }
    nloc = mine > 0u ? mine : 1u; nx = cnt > 0u ? cnt : 1u;
}
__device__ __forceinline__ void xcd_barrier(const Params& p, char* smem) {
    XcdBarrier b; b.bar = (unsigned*)(p.ws + OFF_CTRL); b.x = xb_xcc_id(); b.st = (volatile LAS unsigned*)((LAS char*)smem + SMEM_BYTES - 16);
    asm volatile("s_waitcnt vmcnt(0)" ::: "memory");
    __syncthreads();
    if (ltid() == 0) {
        unsigned* bar = b.bar;
        __builtin_amdgcn_s_waitcnt(0);
        unsigned nloc = b.st[0], nx = b.st[1];
        if (nloc == 0u) { xcd_barrier_complete(bar, b.x, nloc, nx); b.st[0] = nloc; b.st[1] = nx; }
        const unsigned old = xb_add(&bar[XB_XSUB(b.x)], 1u);
        const unsigned gen = old / nloc;
        if (old + 1u == (gen + 1u) * nloc) {
            __builtin_amdgcn_fence(__ATOMIC_RELEASE, "agent");
            asm volatile("s_waitcnt vmcnt(0)" ::: "memory");
            const unsigned og = xb_add(&bar[XB_TOP], 1u);
            const unsigned tg = og / nx;
            if (og + 1u == (tg + 1u) * nx) xb_add(&bar[XB_TOPGEN], 1u);
            else XB_SPIN(xb_ld(&bar[XB_TOPGEN]) == tg, bar);
            __builtin_amdgcn_fence(__ATOMIC_ACQUIRE, "agent");
            xb_add(&bar[XB_XGEN(b.x)], 1u);
            asm volatile("s_waitcnt vmcnt(0)" ::: "memory");
        } else {
            XB_SPIN(xb_ld(&bar[XB_XGEN(b.x)]) == gen, bar);
            __builtin_amdgcn_fence(__ATOMIC_ACQUIRE, "agent");
            asm volatile("s_waitcnt vmcnt(0)" ::: "memory");
        }
    }
    __syncthreads();
}
template <int Q>
__device__ __forceinline__ void mega_phase(const Params& p, int l, char* smem, int xb, int rep = 0) {
    int n = kind_items(Q);
    if (Q == 7 && l == 0) n += CONV_PER_LAYER + 144;
#ifdef DUP6_PREP_ONLY
    if (Q == 6 && rep == 1) n = 1024;
#endif

    if constexpr (Q == 6 || Q == 7) {
        int* ctr = (int*)(p.ws + OFF_CTRL) + CTR_WORD0 + l * 16 + Q + rep * 64;
        LAS int* sitem = (LAS int*)((LAS char*)smem + SMEM_BYTES - 32);
        for (;;) {
            __syncthreads();
            if (ltid() == 0) *sitem = atomicAdd(ctr, 1);
            __syncthreads();
            const int item = __builtin_amdgcn_readfirstlane(*sitem);
            if (item >= n) break;
            __syncthreads();
            Params q = p; { size_t z = 0; asm volatile("" : "+s"(z)); q.ws = p.ws + z; q.out = p.out + z; }
            run_item<Q>(q, l, item, smem);
        }
    } else {
        int b0 = blockIdx.x; asm volatile("" : "+s"(b0));
        for (int item = b0; item < n; item += gridDim.x) {
            __syncthreads();
            Params q = p; { size_t z = 0; asm volatile("" : "+s"(z)); q.ws = p.ws + z; q.out = p.out + z; }
            run_item<Q>(q, l, item, smem);
        }
    }
    xcd_barrier(p, smem);
}

__global__ void __launch_bounds__(256, 2) k_mega(Params p) {
    __shared__ __attribute__((aligned(16))) char smem[SMEM_BYTES];
    if (p.ws == nullptr) cg::this_grid().sync();
    volatile LAS unsigned* stw = (volatile LAS unsigned*)(smem + SMEM_BYTES - 16);
    if (ltid() == 0) { stw[0] = 0u; stw[1] = 0u; }
    __syncthreads();
    (void)xcd_barrier_post((unsigned*)(p.ws + OFF_CTRL), stw);
    const int grid = 0;
    mega_phase<13>(p, 0, smem, grid);
#ifdef DUP13
    mega_phase<13>(p, 0, smem, grid, 1);
#endif

    for (int l = 0; l < 2; ++l) {
        mega_phase<0>(p, l, smem, grid);
#if defined(DUPQ) && DUPQ == 0
        mega_phase<0>(p, l, smem, grid, 1);
#endif
 mega_phase<1>(p, l, smem, grid);
#ifdef DUP1
        mega_phase<1>(p, l, smem, grid, 1);
#endif
 mega_phase<2>(p, l, smem, grid); mega_phase<3>(p, l, smem, grid);
#if defined(DUPQ) && DUPQ == 3
        mega_phase<3>(p, l, smem, grid, 1);
#endif

        mega_phase<4>(p, l, smem, grid);
#if defined(DUPQ) && DUPQ == 4
        mega_phase<4>(p, l, smem, grid, 1);
#endif
 mega_phase<5>(p, l, smem, grid);
#ifdef DUP5
        mega_phase<5>(p, l, smem, grid, 1);
#endif
 mega_phase<6>(p, l, smem, grid);
#ifdef DUP6
        mega_phase<6>(p, l, smem, grid, 1);
#endif
 mega_phase<7>(p, l, smem, grid);
#ifdef DUP7
        mega_phase<7>(p, l, smem, grid, 1);
#endif

        mega_phase<8>(p, l, smem, grid);
#if defined(DUPQ) && DUPQ == 8
        mega_phase<8>(p, l, smem, grid, 1);
#endif
 mega_phase<9>(p, l, smem, grid); mega_phase<10>(p, l, smem, grid);
#if defined(DUPQ) && DUPQ == 10
        mega_phase<10>(p, l, smem, grid, 1);
#endif
 mega_phase<11>(p, l, smem, grid);
#if defined(DUPQ) && DUPQ == 11
        mega_phase<11>(p, l, smem, grid, 1);
#endif

        mega_phase<12>(p, l, smem, grid);
    }
    mega_phase<14>(p, 0, smem, grid);
}

#else
template <int Q> static void launch_kind(const Params& p, int l, hipStream_t stream) {
    hipLaunchKernelGGL(k_phase<Q>, dim3(kind_items(Q)), dim3(256), 0, stream, p, l);
}

#endif
extern "C" void kernel_launch(void* const* d_in, const int* in_sizes, int n_in, void* d_out, int out_size, void* d_ws, size_t ws_size, hipStream_t stream) {
    Params p{};
    const float** pp = (const float**)&p;
    for (int i = 0; i < 30; ++i) pp[i] = (const float*)d_in[i];
    p.out = (float*)d_out; p.ws = (char*)d_ws;
    if (ws_size < WS_TOTAL) { fprintf(stderr, "workspace too small: %zu < %zu\n", ws_size, (size_t)WS_TOTAL); return; }
#if MEGA
    hipMemsetAsync(d_ws, 0, 16384, stream);
    static int grid_blocks = 0;
    if (!grid_blocks) {
        int dev = 0, cus = 0, per_cu = 0;
        hipGetDevice(&dev); hipDeviceGetAttribute(&cus, hipDeviceAttributeMultiprocessorCount, dev);
        hipOccupancyMaxActiveBlocksPerMultiprocessor(&per_cu, k_mega, 256, 0);
        if (per_cu > 2) per_cu = 2;
        grid_blocks = cus * per_cu;
    }
    void* args[] = {&p};
    hipError_t err = hipLaunchCooperativeKernel((void*)k_mega, dim3(grid_blocks), dim3(256), args, 0, stream);
    if (err != hipSuccess) fprintf(stderr, "cooperative launch failed: %s (grid %d)\n", hipGetErrorString(err), grid_blocks);
#else
#ifndef DBG_STOP
#define DBG_STOP 99
#endif
    if (DBG_STOP < 99) hipMemsetAsync(d_out, 0, (size_t)out_size * 4, stream);
    launch_kind<13>(p, 0, stream);
    for (int l = 0; l < 2; ++l) {
        const int lim = DBG_STOP - 13 * l;
        if (lim > 0) launch_kind<0>(p, l, stream);
        if (lim > 1) launch_kind<1>(p, l, stream);
        if (lim > 2) launch_kind<2>(p, l, stream);
        if (lim > 3) launch_kind<3>(p, l, stream);
        if (lim > 4) launch_kind<4>(p, l, stream);
        if (lim > 5) launch_kind<5>(p, l, stream);
        if (lim > 6) launch_kind<6>(p, l, stream);
        if (lim > 7) launch_kind<7>(p, l, stream);
        if (lim > 8) launch_kind<8>(p, l, stream);
        if (lim > 9) launch_kind<9>(p, l, stream);
        if (lim > 10) launch_kind<10>(p, l, stream);
        if (lim > 11) launch_kind<11>(p, l, stream);
        if (lim > 12) launch_kind<12>(p, l, stream);
    }
    launch_kind<14>(p, 0, stream);
#endif
}
```
